# Optimizing an MI355X kernel written in HIP

```python
import math
import jax
import jax.numpy as jnp
from jax import lax
import numpy as np

D_MODEL = 1024
BATCH = 2
SEQ = 8192
DEPTH = 2

GROUP_W = D_MODEL // 4
SSM_HEADS = 4
SSM_HEAD_DIM = GROUP_W // SSM_HEADS
SSM_GROUPS = 2
SSM_STATE = 128
SSM_CONV = 4
SSM_CHUNK = 128
SSM_XBC = GROUP_W + 2 * SSM_GROUPS * SSM_STATE
MLA_HEADS = 4
MLA_NOPE = 64
MLA_ROPE = 32
MLA_V = GROUP_W // MLA_HEADS
MLA_Q_RANK = 256
MLA_KV_RANK = 128
RET_HEADS = 4
RET_DK = 64
RET_DV = GROUP_W // RET_HEADS
RET_CHUNK = 128
NSA_HEADS = 4
NSA_DK = 64
NSA_DV = GROUP_W // NSA_HEADS
NSA_CMP_LEN = 32
NSA_CMP_STRIDE = 16
NSA_CMP_HID = 256
NSA_SLC_LEN = 64
NSA_TOPN = 16
NSA_WIN = 512
D_FF = 4 * D_MODEL
Q_BLOCK = 128
ROPE_THETA = 10000.0
EPS = 1e-5
NEG_INF = -1e30
FORCED_SCORE = 1e9
DEEPNORM_ALPHA = (2.0 * DEPTH) ** 0.25
DEEPNORM_BETA = (8.0 * DEPTH) ** -0.25

IN_SPLITS = (
    GROUP_W, SSM_XBC, SSM_HEADS,
    MLA_Q_RANK, MLA_KV_RANK, MLA_ROPE,
    RET_HEADS * RET_DK, RET_HEADS * RET_DK, RET_HEADS * RET_DV, GROUP_W,
    NSA_HEADS * NSA_DK, NSA_DK, NSA_DV, NSA_DK, NSA_DV, NSA_DK, NSA_DV, 3 * NSA_HEADS,
)
D_IN = sum(IN_SPLITS)

kernel_name = 'hybrid_ssd_mla_retention_nsa'


def split_columns(proj):
    offsets = [int(o) for o in np.cumsum(IN_SPLITS)[:-1]]
    return jnp.split(proj, offsets, axis=-1)


def layer_norm(x, g, b):
    xf = x.astype(jnp.float32)
    mu = jnp.mean(xf, axis=-1, keepdims=True)
    var = jnp.mean(jnp.square(xf - mu), axis=-1, keepdims=True)
    return ((xf - mu) * lax.rsqrt(var + EPS)).astype(x.dtype) * g + b


def rms_norm(x, g=None):
    xf = x.astype(jnp.float32)
    y = (xf * lax.rsqrt(jnp.mean(xf * xf, axis=-1, keepdims=True) + EPS)).astype(x.dtype)
    return y if g is None else y * g


def rope_tables(seq, dim):
    inv = ROPE_THETA ** (-jnp.arange(0, dim, 2, dtype=jnp.float32) / dim)
    ang = jnp.arange(seq, dtype=jnp.float32)[:, None] * inv[None, :]
    return jnp.cos(ang), jnp.sin(ang)


def apply_rope(x, cos, sin):
    x1, x2 = jnp.split(x, 2, axis=-1)
    c = cos[:, None, :].astype(x.dtype)
    s = sin[:, None, :].astype(x.dtype)
    return jnp.concatenate([x1 * c - x2 * s, x1 * s + x2 * c], axis=-1)


def causal_block_attention(q, k, v):
    bsz, S, H, D = q.shape
    nb = S // Q_BLOCK
    q_b = jnp.moveaxis(q.reshape(bsz, nb, Q_BLOCK, H, D), 1, 0)
    kpos = jnp.arange(S)

    def one_block(args):
        i, qi = args
        qpos = i * Q_BLOCK + jnp.arange(Q_BLOCK)
        s = jnp.einsum('bqhd,bkhd->bhqk', qi, k).astype(jnp.float32)
        s = jnp.where(kpos[None, :] <= qpos[:, None], s, NEG_INF)
        p = jax.nn.softmax(s, axis=-1).astype(v.dtype)
        return jnp.einsum('bhqk,bkhd->bqhd', p, v)

    out = lax.map(one_block, (jnp.arange(nb), q_b))
    return jnp.moveaxis(out, 0, 1).reshape(bsz, S, H, v.shape[-1])


def causal_depthwise_conv(u, w, b):
    y = lax.conv_general_dilated(u, w[:, None, :], window_strides=(1,), padding=[(SSM_CONV - 1, 0)],
                                 dimension_numbers=('NWC', 'WIO', 'NWC'), feature_group_count=u.shape[-1])
    return y + b


def segsum_exp(a):
    T = a.shape[-1]
    cs = jnp.cumsum(a, axis=-1)
    diff = cs[..., :, None] - cs[..., None, :]
    mask = jnp.tril(jnp.ones((T, T), dtype=bool))
    return jnp.where(mask, jnp.exp(jnp.where(mask, diff, 0.0)), 0.0)


def mamba2_ssd(z, xbc, dt_raw, conv_w, conv_b, dt_bias, a_log, d_skip, norm_g):
    bsz, S, _ = z.shape
    H, P, N, L = SSM_HEADS, SSM_HEAD_DIM, SSM_STATE, SSM_CHUNK
    nc = S // L
    xbc = jax.nn.silu(causal_depthwise_conv(xbc, conv_w, conv_b))
    xs, b_in, c_in = jnp.split(xbc, [GROUP_W, GROUP_W + SSM_GROUPS * N], axis=-1)
    xs = xs.reshape(bsz, S, H, P)
    rep = H // SSM_GROUPS
    b_h = jnp.repeat(b_in.reshape(bsz, S, SSM_GROUPS, N), rep, axis=2)
    c_h = jnp.repeat(c_in.reshape(bsz, S, SSM_GROUPS, N), rep, axis=2)
    dt = jax.nn.softplus(dt_raw + dt_bias)
    a = jnp.moveaxis((dt * -jnp.exp(a_log)).reshape(bsz, nc, L, H), 3, 1)
    xdt = (xs * dt[..., None]).reshape(bsz, nc, L, H, P)
    bc = b_h.reshape(bsz, nc, L, H, N)
    cc = c_h.reshape(bsz, nc, L, H, N)
    a_cs = jnp.cumsum(a, axis=-1)
    scores = jnp.einsum('bclhn,bcshn->bhcls', cc, bc) * segsum_exp(a)
    y_diag = jnp.einsum('bhcls,bcshp->bclhp', scores, xdt)
    decay_to_end = jnp.exp(a_cs[..., -1:] - a_cs)
    states = jnp.einsum('bclhn,bhcl,bclhp->bchpn', bc, decay_to_end, xdt)
    chunk_decay = jnp.exp(a_cs[..., -1])

    def step(h_state, inp):
        st, dec = inp
        return h_state * dec[..., None, None] + st, h_state

    _, prev = lax.scan(step, jnp.zeros_like(states[:, 0]),
                       (jnp.moveaxis(states, 1, 0), jnp.moveaxis(chunk_decay, 2, 0)))
    prev = jnp.moveaxis(prev, 0, 1)
    y_off = jnp.einsum('bclhn,bchpn,bhcl->bclhp', cc, prev, jnp.exp(a_cs))
    y = (y_diag + y_off).reshape(bsz, S, H, P) + xs * d_skip[:, None]
    y = y.reshape(bsz, S, GROUP_W) * jax.nn.silu(z)
    return rms_norm(y, norm_g)


def mla(c_q, c_kv, k_rope, q_norm_g, w_uq, kv_norm_g, w_ukv, cos, sin):
    bsz, S, _ = c_q.shape
    H = MLA_HEADS
    q = (rms_norm(c_q, q_norm_g) @ w_uq).reshape(bsz, S, H, MLA_NOPE + MLA_ROPE)
    q_nope, q_pe = jnp.split(q, [MLA_NOPE], axis=-1)
    q = jnp.concatenate([q_nope, apply_rope(q_pe, cos, sin)], axis=-1) * ((MLA_NOPE + MLA_ROPE) ** -0.5)
    kv = (rms_norm(c_kv, kv_norm_g) @ w_ukv).reshape(bsz, S, H, MLA_NOPE + MLA_V)
    k_nope, v = jnp.split(kv, [MLA_NOPE], axis=-1)
    k_pe = jnp.broadcast_to(apply_rope(k_rope[:, :, None, :], cos, sin), (bsz, S, H, MLA_ROPE))
    k = jnp.concatenate([k_nope, k_pe], axis=-1)
    return causal_block_attention(q, k, v).reshape(bsz, S, GROUP_W)


def retention(q, k, v, gate, cos, sin):
    bsz, S, _ = q.shape
    H, dk, dv, L = RET_HEADS, RET_DK, RET_DV, RET_CHUNK
    nc = S // L
    dt = q.dtype
    q = apply_rope(q.reshape(bsz, S, H, dk), cos, sin)
    k = apply_rope(k.reshape(bsz, S, H, dk), cos, sin) * (dk ** -0.5)
    qc = q.reshape(bsz, nc, L, H, dk)
    kc = k.reshape(bsz, nc, L, H, dk)
    vc = v.reshape(bsz, nc, L, H, dv)
    log_gamma = jnp.log1p(-jnp.exp2(-5.0 - jnp.arange(H, dtype=jnp.float32)))
    pos = jnp.arange(L, dtype=jnp.float32)
    diff = pos[:, None] - pos[None, :]
    decay_in = jnp.where(diff >= 0, jnp.exp(jnp.maximum(diff, 0.0)[None] * log_gamma[:, None, None]), 0.0).astype(dt)
    zeta = jnp.exp((L - 1 - pos)[None] * log_gamma[:, None]).astype(dt)
    xi = jnp.exp((pos + 1.0)[None] * log_gamma[:, None]).astype(dt)
    chunk_decay = jnp.exp(L * log_gamma).astype(dt)
    scores = jnp.einsum('bclhd,bcshd->bhcls', qc, kc) * decay_in[None, :, None]
    y_in = jnp.einsum('bhcls,bcshv->bclhv', scores, vc)
    kv = jnp.einsum('bclhd,hl,bclhv->bchdv', kc, zeta, vc)

    def step(state, kv_c):
        return state * chunk_decay[None, :, None, None] + kv_c, state

    _, prev = lax.scan(step, jnp.zeros_like(kv[:, 0]), jnp.moveaxis(kv, 1, 0))
    prev = jnp.moveaxis(prev, 0, 1)
    y_cross = jnp.einsum('bclhd,hl,bchdv->bclhv', qc, xi, prev)
    y = rms_norm((y_in + y_cross).reshape(bsz, S, H, dv))
    return y.reshape(bsz, S, GROUP_W) * jax.nn.silu(gate)


def nsa(q, k_cmp_raw, v_cmp_raw, k_slc, v_slc, k_win, v_win, gate_logits,
        pe_k, w1_k, w2_k, pe_v, w1_v, w2_v):
    bsz, S, _ = q.shape
    H, dk, dv = NSA_HEADS, NSA_DK, NSA_DV
    f32 = jnp.float32
    q = q.reshape(bsz, S, H, dk) * (dk ** -0.5)
    gates = jax.nn.sigmoid(gate_logits.reshape(bsz, S, H, 3))
    slopes = jnp.exp2(-8.0 * jnp.arange(1, H + 1, dtype=f32) / H)
    n_cmp = (S - NSA_CMP_LEN) // NSA_CMP_STRIDE + 1
    cmp_start = jnp.arange(n_cmp) * NSA_CMP_STRIDE
    cmp_tok = cmp_start[:, None] + jnp.arange(NSA_CMP_LEN)[None, :]
    cmp_end = cmp_start + NSA_CMP_LEN - 1
    cmp_center = cmp_start.astype(f32) + 0.5 * (NSA_CMP_LEN - 1)

    def compress(u, pe, w1, w2):
        blocks = (u[:, cmp_tok] + pe).reshape(bsz, n_cmp, NSA_CMP_LEN * u.shape[-1])
        return jax.nn.silu(blocks @ w1) @ w2

    k_cmp = compress(k_cmp_raw, pe_k, w1_k, w2_k)
    v_cmp = compress(v_cmp_raw, pe_v, w1_v, w2_v)
    n_slc = S // NSA_SLC_LEN
    top_n = min(NSA_TOPN, n_slc)
    slc_start = jnp.arange(n_slc) * NSA_SLC_LEN
    overlap = ((cmp_start[:, None] < slc_start[None, :] + NSA_SLC_LEN)
               & (cmp_end[:, None] >= slc_start[None, :])).astype(f32)
    k_blocks = k_slc.reshape(bsz, n_slc, NSA_SLC_LEN, dk)
    v_blocks = v_slc.reshape(bsz, n_slc, NSA_SLC_LEN, dv)
    bidx = jnp.arange(bsz)[:, None, None]
    k_win_pad = jnp.pad(k_win, ((0, 0), (NSA_WIN, 0), (0, 0)))
    v_win_pad = jnp.pad(v_win, ((0, 0), (NSA_WIN, 0), (0, 0)))
    nb = S // Q_BLOCK
    q_b = jnp.moveaxis(q.reshape(bsz, nb, Q_BLOCK, H, dk), 1, 0)
    g_b = jnp.moveaxis(gates.reshape(bsz, nb, Q_BLOCK, H, 3), 1, 0)

    def one_block(args):
        i, qi, gi = args
        qpos = i * Q_BLOCK + jnp.arange(Q_BLOCK)
        qpos_f = qpos.astype(f32)
        valid_c = cmp_end[None, :] <= qpos[:, None]
        s_c = (jnp.einsum('bqhd,bnd->bhqn', qi, k_cmp).astype(f32)
               - slopes[:, None, None] * (qpos_f[:, None] - cmp_center[None, :]))
        s_c = jnp.where(valid_c, s_c, NEG_INF)
        p_c = jax.nn.softmax(s_c, axis=-1) * jnp.any(valid_c, axis=-1)[:, None].astype(f32)
        o_c = jnp.einsum('bhqn,bnd->bqhd', p_c.astype(v_cmp.dtype), v_cmp)
        imp = jnp.einsum('bhqn,nj->bqj', p_c, overlap)
        blk = jnp.arange(n_slc)
        q_blk = qpos // NSA_SLC_LEN
        causal_blk = slc_start[None, :] <= qpos[:, None]
        forced = (blk[None, :] == 0) | (blk[None, :] == q_blk[:, None]) | (blk[None, :] == q_blk[:, None] - 1)
        imp = jnp.where(forced & causal_blk, FORCED_SCORE, imp)
        imp = jnp.where(causal_blk, imp, -1.0)
        _, sel = lax.top_k(imp, top_n)
        k_sel = k_blocks[bidx, sel].reshape(bsz, Q_BLOCK, top_n * NSA_SLC_LEN, dk)
        v_sel = v_blocks[bidx, sel].reshape(bsz, Q_BLOCK, top_n * NSA_SLC_LEN, dv)
        pos_sel = (sel[..., None] * NSA_SLC_LEN + jnp.arange(NSA_SLC_LEN)).reshape(bsz, Q_BLOCK, -1)
        dist_s = (qpos[None, :, None] - pos_sel).astype(f32)
        s_s = (jnp.einsum('bqhd,bqkd->bhqk', qi, k_sel).astype(f32)
               - slopes[None, :, None, None] * dist_s[:, None])
        s_s = jnp.where((dist_s >= 0)[:, None], s_s, NEG_INF)
        p_s = jax.nn.softmax(s_s, axis=-1).astype(v_sel.dtype)
        o_s = jnp.einsum('bhqk,bqkd->bqhd', p_s, v_sel)
        k_w = lax.dynamic_slice_in_dim(k_win_pad, i * Q_BLOCK, Q_BLOCK + NSA_WIN, axis=1)
        v_w = lax.dynamic_slice_in_dim(v_win_pad, i * Q_BLOCK, Q_BLOCK + NSA_WIN, axis=1)
        kpos = i * Q_BLOCK - NSA_WIN + jnp.arange(Q_BLOCK + NSA_WIN)
        dist_w = qpos[:, None] - kpos[None, :]
        valid_w = (dist_w >= 0) & (dist_w < NSA_WIN) & (kpos[None, :] >= 0)
        s_w = (jnp.einsum('bqhd,bkd->bhqk', qi, k_w).astype(f32)
               - slopes[:, None, None] * dist_w.astype(f32))
        s_w = jnp.where(valid_w, s_w, NEG_INF)
        p_w = jax.nn.softmax(s_w, axis=-1).astype(v_w.dtype)
        o_w = jnp.einsum('bhqk,bkd->bqhd', p_w, v_w)
        return gi[..., 0:1] * o_c + gi[..., 1:2] * o_s + gi[..., 2:3] * o_w

    out = lax.map(one_block, (jnp.arange(nb), q_b, g_b))
    return jnp.moveaxis(out, 0, 1).reshape(bsz, S, GROUP_W)


def setup_inputs(seed: int = 0) -> dict:
    key = jax.random.key(seed)
    ks = jax.random.split(key, 32)
    f32 = jnp.float32
    L = DEPTH

    def nrm(k, shape, fan_in, scale=1.0):
        return jax.random.normal(k, shape, f32) * (scale * fan_in ** -0.5)

    def gain(k, shape):
        return 1.0 + 0.02 * jax.random.normal(k, shape, f32)

    def small(k, shape):
        return 0.02 * jax.random.normal(k, shape, f32)

    x = jax.random.normal(ks[0], (BATCH, SEQ, D_MODEL), f32)
    dt0 = jnp.exp(jax.random.uniform(ks[6], (L, SSM_HEADS), f32, math.log(1e-3), math.log(1e-1)))
    return {
        'x': x,
        'ln_emb_g': gain(ks[1], (D_MODEL,)),
        'ln_emb_b': small(ks[2], (D_MODEL,)),
        'w_in': nrm(ks[3], (L, D_MODEL, D_IN), D_MODEL),
        'conv_w': nrm(ks[4], (L, SSM_CONV, SSM_XBC), SSM_CONV),
        'conv_b': small(ks[5], (L, SSM_XBC)),
        'dt_bias': dt0 + jnp.log(-jnp.expm1(-dt0)),
        'a_log': jnp.log(jax.random.uniform(ks[7], (L, SSM_HEADS), f32, 1.0, 16.0)),
        'd_skip': gain(ks[8], (L, SSM_HEADS)),
        'ssm_norm_g': gain(ks[9], (L, GROUP_W)),
        'q_norm_g': gain(ks[10], (L, MLA_Q_RANK)),
        'w_uq': nrm(ks[11], (L, MLA_Q_RANK, MLA_HEADS * (MLA_NOPE + MLA_ROPE)), MLA_Q_RANK),
        'kv_norm_g': gain(ks[12], (L, MLA_KV_RANK)),
        'w_ukv': nrm(ks[13], (L, MLA_KV_RANK, MLA_HEADS * (MLA_NOPE + MLA_V)), MLA_KV_RANK),
        'cmp_pe_k': small(ks[14], (L, NSA_CMP_LEN, NSA_DK)),
        'cmp_w1_k': nrm(ks[15], (L, NSA_CMP_LEN * NSA_DK, NSA_CMP_HID), NSA_CMP_LEN * NSA_DK),
        'cmp_w2_k': nrm(ks[16], (L, NSA_CMP_HID, NSA_DK), NSA_CMP_HID),
        'cmp_pe_v': small(ks[17], (L, NSA_CMP_LEN, NSA_DV)),
        'cmp_w1_v': nrm(ks[18], (L, NSA_CMP_LEN * NSA_DV, NSA_CMP_HID), NSA_CMP_LEN * NSA_DV),
        'cmp_w2_v': nrm(ks[19], (L, NSA_CMP_HID, NSA_DV), NSA_CMP_HID),
        'w_out': nrm(ks[20], (L, D_MODEL, D_MODEL), D_MODEL, DEEPNORM_BETA),
        'ln1_g': gain(ks[21], (L, D_MODEL)),
        'ln1_b': small(ks[22], (L, D_MODEL)),
        'w_mlp1': nrm(ks[23], (L, D_MODEL, D_FF), D_MODEL),
        'w_mlp2': nrm(ks[24], (L, D_FF, D_MODEL), D_FF, DEEPNORM_BETA),
        'ln2_g': gain(ks[25], (L, D_MODEL)),
        'ln2_b': small(ks[26], (L, D_MODEL)),
    }


def reference(x, ln_emb_g, ln_emb_b, w_in, conv_w, conv_b, dt_bias, a_log, d_skip, ssm_norm_g,
              q_norm_g, w_uq, kv_norm_g, w_ukv, cmp_pe_k, cmp_w1_k, cmp_w2_k, cmp_pe_v, cmp_w1_v,
              cmp_w2_v, w_out, ln1_g, ln1_b, w_mlp1, w_mlp2, ln2_g, ln2_b):
    S = x.shape[1]
    cos_m, sin_m = rope_tables(S, MLA_ROPE)
    cos_r, sin_r = rope_tables(S, RET_DK)
    h = layer_norm(x, ln_emb_g, ln_emb_b)
    for l in range(DEPTH):
        (ssm_z, ssm_xbc, ssm_dt, mla_cq, mla_ckv, mla_kr, ret_q, ret_k, ret_v, ret_g,
         nsa_q, nsa_kc, nsa_vc, nsa_ks, nsa_vs, nsa_kw, nsa_vw, nsa_gate) = split_columns(h @ w_in[l])
        y_a = mamba2_ssd(ssm_z, ssm_xbc, ssm_dt, conv_w[l], conv_b[l], dt_bias[l], a_log[l], d_skip[l], ssm_norm_g[l])
        y_b = mla(mla_cq, mla_ckv, mla_kr, q_norm_g[l], w_uq[l], kv_norm_g[l], w_ukv[l], cos_m, sin_m)
        y_c = retention(ret_q, ret_k, ret_v, ret_g, cos_r, sin_r)
        y_d = nsa(nsa_q, nsa_kc, nsa_vc, nsa_ks, nsa_vs, nsa_kw, nsa_vw, nsa_gate,
                  cmp_pe_k[l], cmp_w1_k[l], cmp_w2_k[l], cmp_pe_v[l], cmp_w1_v[l], cmp_w2_v[l])
        mix = jnp.concatenate([y_a, y_b, y_c, y_d], axis=-1) @ w_out[l]
        h = layer_norm(DEEPNORM_ALPHA * h + mix, ln1_g[l], ln1_b[l])
        ff = jnp.square(jax.nn.relu(h @ w_mlp1[l])) @ w_mlp2[l]
        h = layer_norm(DEEPNORM_ALPHA * h + ff, ln2_g[l], ln2_b[l])
    return h
```

```cpp
#include <hip/hip_runtime.h>
#include <hip/hip_cooperative_groups.h>
#include <cstdio>
namespace cg = cooperative_groups;

#ifndef MEGA
#define MEGA 1
#endif

typedef unsigned short u16;
typedef unsigned long long u64;
typedef __attribute__((ext_vector_type(8))) short bf16x8;
typedef __attribute__((ext_vector_type(4))) float f32x4;
typedef unsigned __attribute__((ext_vector_type(4))) u32x4;
typedef unsigned __attribute__((ext_vector_type(2))) u32x2;
#define LAS __attribute__((address_space(3)))
#define GAS __attribute__((address_space(1)))
#define MFMA(a, b, c) __builtin_amdgcn_mfma_f32_16x16x32_bf16(a, b, c, 0, 0, 0)

constexpr int S_ = 8192, T_ = 16384, DM_ = 1024, DINP_ = 3200, DFF_ = 4096;
constexpr int C_Z = 0, C_XS = 256, C_CQ = 1024, C_CKV = 1280, C_KR = 1408, C_RQ = 1440, C_RK = 1696, C_RV = 1952,
              C_RG = 2208, C_NQ = 2464, C_NKC = 2720, C_NVC = 2784, C_NKS = 2848, C_NVS = 2912, C_NKW = 2976,
              C_NVW = 3040, C_DT = 3104, C_GATE = 3108;
constexpr float EPS_ = 1e-5f;
constexpr float ALPHA_ = 1.41421356237309515f;

constexpr size_t OFF_WT_IN = 0, OFF_WT_OUT = 6553600, OFF_WT_M1 = 8650752, OFF_WT_M2 = 17039360, OFF_WT_UQ = 25427968,
                 OFF_WT_UKV = 25624576, OFF_WT_C1K = 25755648, OFF_WT_C1V = 26804224, OFF_WT_C2K = 27852800,
                 OFF_WT_C2V = 27918336, OFF_BIASP = 27983872, OFF_COSM = 28016640, OFF_SINM = 28540928,
                 OFF_COSR = 29065216, OFF_SINR = 30113792, OFF_CNT = 31162368, OFF_SSDDEC = 31166464,
                 OFF_R = 31170560, OFF_HBF = 165388288, OFF_QMLA = 198942720, OFF_KBUF = 211525632,
                 OFF_VTMLA = 224108544, OFF_VST = 232497152, OFF_VWT = 234594304, OFF_BAR = 236691456, OFF_SSQ = 236691456 + 16384, OFF_MLAP = 236969984, OFF_MLAML = 257941504, OFF_LNST = 259252224, WS_TOTAL = 259252224 + 262144;
constexpr size_t R_PROJ = 0, R_SSDST = 105267200, R_RETST = 122044416, R_HID = 130433024, R_KCMP = 131481600,
                 R_VCT = 131612672;

constexpr int SMEM_BYTES = 75776;
constexpr int GSTR = 72;
constexpr int TSTR = 136;

struct Params {
  const float* in[27];
  float* h32;
  char* ws;
};
enum { I_X = 0, I_LNEG, I_LNEB, I_WIN, I_CONVW, I_CONVB, I_DTB, I_ALOG, I_DSKIP, I_SSMG, I_QNG, I_WUQ, I_KVNG, I_WUKV,
       I_PEK, I_W1K, I_W2K, I_PEV, I_W1V, I_W2V, I_WOUT, I_LN1G, I_LN1B, I_WM1, I_WM2, I_LN2G, I_LN2B };


__device__ __forceinline__ int TIDX() { int t = __builtin_amdgcn_workitem_id_x(); asm volatile("" : "+v"(t)); return t; }

__device__ __forceinline__ char* WSP(const Params& p) { GAS char* w = (GAS char*)p.ws; asm volatile("" : "+s"(w)); return (char*)w; }
__device__ __forceinline__ const float* INP(const Params& p, int i) { GAS const float* q = (GAS const float*)p.in[i]; asm volatile("" : "+s"(q)); return (const float*)q; }
union U8 { u32x4 u; bf16x8 v; u16 s[8]; unsigned w[4]; u64 d[2]; };

__device__ __forceinline__ float bf2f(u16 v) { return __uint_as_float(((unsigned)v) << 16); }
typedef __bf16 bf16v2_t __attribute__((ext_vector_type(2)));
typedef float floatv2_t __attribute__((ext_vector_type(2)));
__device__ __forceinline__ u16 f2bf(float f) { return __builtin_bit_cast(u16, (__bf16)f); }
__device__ __forceinline__ unsigned pack2(float a, float b) { floatv2_t f = {a, b}; return __builtin_bit_cast(unsigned, __builtin_convertvector(f, bf16v2_t)); }
__device__ __forceinline__ float silu_f(float x) { return x * __builtin_amdgcn_rcpf(1.f + __expf(-x)); }
__device__ __forceinline__ float sigm_f(float x) { return __builtin_amdgcn_rcpf(1.f + __expf(-x)); }
__device__ __forceinline__ float dpp_xor1(float v) { return __int_as_float(__builtin_amdgcn_mov_dpp(__float_as_int(v), 0xB1, 0xF, 0xF, true)); }
__device__ __forceinline__ float dpp_xor2(float v) { return __int_as_float(__builtin_amdgcn_mov_dpp(__float_as_int(v), 0x4E, 0xF, 0xF, true)); }
__device__ __forceinline__ float wave_sum(float v) {
#pragma unroll
  for (int o = 32; o > 0; o >>= 1) v += __shfl_xor(v, o);
  return v;
}
__device__ __forceinline__ const u16* PROJ(const Params& p) { return (const u16*)(WSP(p) + OFF_R + R_PROJ); }

__device__ __forceinline__ int next_item(int* counter, char* smem) {
  int* sh = (int*)(smem + SMEM_BYTES - 16);
  __syncthreads();
  if (TIDX() == 0) *sh = atomicAdd(counter, 1);
  __syncthreads();
  return *sh;
}

struct NoMid { __device__ __forceinline__ void operator()(int, f32x4 (&)[4][4]) const {} };
template <bool SWAP, class ARow, class Epi, class Mid = NoMid>
__device__ __forceinline__ void gemm_tile(ARow arow, const int a_kstride, const u16* __restrict__ Bt, const int ldb,
                                          const int K, const int n0, Epi epi, u16* smem, Mid mid = NoMid()) {
  const int tid = TIDX(), lane = tid & 63, wave = tid >> 6;
  const int wm = wave >> 1, wn = wave & 1, lr = lane & 15, quad = lane >> 4;
  const int srow = tid >> 3, sch = tid & 7;
  const u16* ap[4];
  const u16* bp[4];
#pragma unroll
  for (int i = 0; i < 4; ++i) {
    const int r = srow + i * 32;
    const int gch = sch ^ ((r >> 1) & 7);
    ap[i] = arow(r) + gch * 8;
    bp[i] = Bt + (long)(n0 + r) * ldb + gch * 8;
  }
  f32x4 acc[4][4];
#pragma unroll
  for (int i = 0; i < 4; ++i)
#pragma unroll
    for (int j = 0; j < 4; ++j) acc[i][j] = (f32x4){0.f, 0.f, 0.f, 0.f};
  const int nkt = K >> 6;
#define GEMM_STAGE(KT, BUF)                                                                                   \
  {                                                                                                            \
    u16* ab_ = smem + (BUF) * 16384;                                                                           \
    _Pragma("unroll") for (int i = 0; i < 4; ++i) {                                                            \
      __builtin_amdgcn_global_load_lds((GAS const unsigned*)(ap[i] + (long)(KT) * a_kstride),                  \
                                       (LAS unsigned*)(ab_ + (srow + i * 32) * 64 + sch * 8), 16, 0, 0);       \
      __builtin_amdgcn_global_load_lds((GAS const unsigned*)(bp[i] + (KT) * 64),                               \
                                       (LAS unsigned*)(ab_ + 8192 + (srow + i * 32) * 64 + sch * 8), 16, 0, 0); \
    }                                                                                                          \
  }
  __syncthreads();
  GEMM_STAGE(0, 0)
  int aoff[4], boff[4];
#pragma unroll
  for (int mi = 0; mi < 4; ++mi) { const int r = wm * 64 + mi * 16 + lr; aoff[mi] = r * 64; }
#pragma unroll
  for (int ni = 0; ni < 4; ++ni) { const int r = wn * 64 + ni * 16 + lr; boff[ni] = 8192 + r * 64; }
  const int swz = (lr >> 1) & 7;
#pragma unroll 1
  for (int kt = 0; kt < nkt; ++kt) {
    asm volatile("s_waitcnt vmcnt(0)" ::: "memory");
    __syncthreads();
    if (kt + 1 < nkt) GEMM_STAGE(kt + 1, (kt + 1) & 1)
    const u16* buf = smem + (kt & 1) * 16384;
    {
      bf16x8 a[2][4], b[2][4];
#pragma unroll
      for (int ks = 0; ks < 2; ++ks) {
        const int coff = ((ks * 4 + quad) ^ swz) * 8;
#pragma unroll
        for (int mi = 0; mi < 4; ++mi) a[ks][mi] = *(const bf16x8*)(buf + aoff[mi] + coff);
#pragma unroll
        for (int ni = 0; ni < 4; ++ni) b[ks][ni] = *(const bf16x8*)(buf + boff[ni] + coff);
      }
      __builtin_amdgcn_sched_barrier(0);
#pragma unroll
      for (int ks = 0; ks < 2; ++ks)
#pragma unroll
        for (int mi = 0; mi < 4; ++mi)
#pragma unroll
          for (int ni = 0; ni < 4; ++ni)
            acc[mi][ni] = SWAP ? MFMA(b[ks][ni], a[ks][mi], acc[mi][ni]) : MFMA(a[ks][mi], b[ks][ni], acc[mi][ni]);
    }
    mid(kt, acc);
  }
#undef GEMM_STAGE
#pragma unroll
  for (int mi = 0; mi < 4; ++mi) {
#pragma unroll
    for (int ni = 0; ni < 4; ++ni) {
      if (SWAP) epi(wm * 64 + mi * 16 + lr, wn * 64 + ni * 16 + quad * 4, acc[mi][ni]);
      else epi(wm * 64 + mi * 16 + quad * 4, wn * 64 + ni * 16 + lr, acc[mi][ni]);
    }
    asm volatile("" ::: "memory");
  }
}

template <int NKS, bool PV, class KF, class VF, class MB, class PH>
__device__ __forceinline__ void flash_tile(KF kf, VF vf, MB mb, PH ph, const bf16x8 (&qf)[NKS][2], f32x4 (&o)[4][2],
                                           float (&m)[2], float (&l)[2]) {
  const int quad = (TIDX() & 63) >> 4;
  f32x4 s[2][4];
#pragma unroll
  for (int kt = 0; kt < 4; ++kt) {
    s[0][kt] = (f32x4){0.f, 0.f, 0.f, 0.f};
    s[1][kt] = (f32x4){0.f, 0.f, 0.f, 0.f};
#pragma unroll
    for (int ks = 0; ks < NKS; ++ks) {
      bf16x8 a = kf(kt, ks);
      s[0][kt] = MFMA(a, qf[ks][0], s[0][kt]);
      s[1][kt] = MFMA(a, qf[ks][1], s[1][kt]);
    }
  }
  bf16x8 pb[2][2];
#pragma unroll
  for (int qt = 0; qt < 2; ++qt) {
    float mx = -INFINITY;
#pragma unroll
    for (int kt = 0; kt < 4; ++kt)
#pragma unroll
      for (int j = 0; j < 4; ++j) {
        float v = mb(kt * 16 + j, qt, s[qt][kt][j]);
        s[qt][kt][j] = v;
        mx = fmaxf(mx, v);
      }
    mx = fmaxf(mx, __shfl_xor(mx, 16));
    mx = fmaxf(mx, __shfl_xor(mx, 32));
    const float mnew = fmaxf(m[qt], mx);
    const float alpha = __builtin_amdgcn_exp2f(m[qt] - mnew);
    m[qt] = mnew;
    float ps = 0.f;
    float pv[4][4];
#pragma unroll
    for (int kt = 0; kt < 4; ++kt)
#pragma unroll
      for (int j = 0; j < 4; ++j) {
        float e = __builtin_amdgcn_exp2f(s[qt][kt][j] - mnew);
        pv[kt][j] = e;
        ps += e;
      }
    l[qt] = l[qt] * alpha + ps;
    ph(qt, pv);
    if (PV) {
#pragma unroll
      for (int dt = 0; dt < 4; ++dt) o[dt][qt] *= alpha;
#pragma unroll
      for (int kk = 0; kk < 2; ++kk) {
        U8 u;
        u.w[0] = pack2(pv[2 * kk][0], pv[2 * kk][1]);
        u.w[1] = pack2(pv[2 * kk][2], pv[2 * kk][3]);
        u.w[2] = pack2(pv[2 * kk + 1][0], pv[2 * kk + 1][1]);
        u.w[3] = pack2(pv[2 * kk + 1][2], pv[2 * kk + 1][3]);
        pb[qt][kk] = u.v;
      }
    }
  }
  if (PV) {
#pragma unroll
    for (int kk = 0; kk < 2; ++kk)
#pragma unroll
      for (int dt = 0; dt < 4; ++dt) {
        bf16x8 a = vf(dt, kk);
        o[dt][0] = MFMA(a, pb[0][kk], o[dt][0]);
        o[dt][1] = MFMA(a, pb[1][kk], o[dt][1]);
      }
  }
}

constexpr float FT_T = 16.f;
template <int NKS, bool PV, class KF, class VF, class CI, class PH>
__device__ __forceinline__ void flash_tile2(KF kf, VF vf, CI cin, PH ph, const bf16x8 (&qf)[NKS][2], f32x4 (&o)[4][2],
                                            float (&m)[2], float (&l)[2]) {
  f32x4 s[2][4];
  if (NKS == 2) {
    bf16x8 kfr[4][NKS];
#pragma unroll
    for (int kt = 0; kt < 4; ++kt)
#pragma unroll
      for (int ks = 0; ks < NKS; ++ks) kfr[kt][ks] = kf(kt, ks);
    __builtin_amdgcn_sched_barrier(0);
#pragma unroll
    for (int kt = 0; kt < 4; ++kt) {
      s[0][kt] = cin(0, kt);
      s[1][kt] = cin(1, kt);
#pragma unroll
      for (int ks = 0; ks < NKS; ++ks) {
        s[0][kt] = MFMA(kfr[kt][ks], qf[ks][0], s[0][kt]);
        s[1][kt] = MFMA(kfr[kt][ks], qf[ks][1], s[1][kt]);
      }
    }
  } else {
    bf16x8 kfr[2][NKS];
#pragma unroll
    for (int ks = 0; ks < NKS; ++ks) kfr[0][ks] = kf(0, ks);
#pragma unroll
    for (int kt = 0; kt < 4; ++kt) {
      if (kt + 1 < 4) {
#pragma unroll
        for (int ks = 0; ks < NKS; ++ks) kfr[(kt + 1) & 1][ks] = kf(kt + 1, ks);
      }
      __builtin_amdgcn_sched_barrier(0);
      s[0][kt] = cin(0, kt);
      s[1][kt] = cin(1, kt);
#pragma unroll
      for (int ks = 0; ks < NKS; ++ks) {
        s[0][kt] = MFMA(kfr[kt & 1][ks], qf[ks][0], s[0][kt]);
        s[1][kt] = MFMA(kfr[kt & 1][ks], qf[ks][1], s[1][kt]);
      }
    }
  }
  float mx[2];
#pragma unroll
  for (int qt = 0; qt < 2; ++qt) {
    float a = -INFINITY;
#pragma unroll
    for (int kt = 0; kt < 4; ++kt) a = fmaxf(a, fmaxf(fmaxf(s[qt][kt][0], s[qt][kt][1]), fmaxf(s[qt][kt][2], s[qt][kt][3])));
    mx[qt] = a;
  }
  const bool un0 = m[0] < -1e29f, un1 = m[1] < -1e29f;
  const bool need = (un0 ? (mx[0] > -INFINITY) : (mx[0] > FT_T)) || (un1 ? (mx[1] > -INFINITY) : (mx[1] > FT_T));
  if (__any(need)) {
#pragma unroll
    for (int qt = 0; qt < 2; ++qt) {
      float mq = mx[qt];
      mq = fmaxf(mq, __shfl_xor(mq, 16));
      mq = fmaxf(mq, __shfl_xor(mq, 32));
      const bool un = m[qt] < -1e29f;
      float delta = 0.f;
      if (un) {
        if (mq > -INFINITY) { delta = mq; m[qt] = mq; }
      } else if (mq > FT_T) {
        delta = mq;
        m[qt] += mq;
        const float sc = __builtin_amdgcn_exp2f(-mq);
        l[qt] *= sc;
        if (PV) {
#pragma unroll
          for (int dt = 0; dt < 4; ++dt) o[dt][qt] *= sc;
        }
      }
#pragma unroll
      for (int kt = 0; kt < 4; ++kt) s[qt][kt] -= delta;
    }
  }
  bf16x8 pb[2][2];
#pragma unroll
  for (int qt = 0; qt < 2; ++qt) {
    float ps = 0.f;
    float pv[4][4];
#pragma unroll
    for (int kt = 0; kt < 4; ++kt)
#pragma unroll
      for (int j = 0; j < 4; ++j) {
        float e = __builtin_amdgcn_exp2f(s[qt][kt][j]);
        pv[kt][j] = e;
        ps += e;
      }
    l[qt] += ps;
    ph(qt, pv);
    if (PV) {
#pragma unroll
      for (int kk = 0; kk < 2; ++kk) {
        U8 u;
        u.w[0] = pack2(pv[2 * kk][0], pv[2 * kk][1]);
        u.w[1] = pack2(pv[2 * kk][2], pv[2 * kk][3]);
        u.w[2] = pack2(pv[2 * kk + 1][0], pv[2 * kk + 1][1]);
        u.w[3] = pack2(pv[2 * kk + 1][2], pv[2 * kk + 1][3]);
        pb[qt][kk] = u.v;
      }
    }
  }
  if (PV) {
    bf16x8 vfr[2][4];
#pragma unroll
    for (int kk = 0; kk < 2; ++kk)
#pragma unroll
      for (int dt = 0; dt < 4; ++dt) vfr[kk][dt] = vf(dt, kk);
#pragma unroll
    for (int kk = 0; kk < 2; ++kk)
#pragma unroll
      for (int dt = 0; dt < 4; ++dt) {
        o[dt][0] = MFMA(vfr[kk][dt], pb[0][kk], o[dt][0]);
        o[dt][1] = MFMA(vfr[kk][dt], pb[1][kk], o[dt][1]);
      }
  }
}
template <bool MASK>
struct AlibiInit {
  float sl, off0, off1;
  int lim0, lim1, win;
  __device__ __forceinline__ f32x4 operator()(int qt, int kt) const {
    const float off = qt ? off1 : off0;
    const int lim = qt ? lim1 : lim0;
    f32x4 c;
#pragma unroll
    for (int j = 0; j < 4; ++j) {
      const int kj = kt * 16 + j;
      float v = __builtin_fmaf(sl, (float)kj, off);
      if (MASK) v = (kj <= lim && kj > lim - win) ? v : -INFINITY;
      c[j] = v;
    }
    return c;
  }
};
__device__ __forceinline__ float ft_shift(float m) { return m < -1e29f ? 0.f : -m; }

struct NoHook { __device__ __forceinline__ void operator()(int, float (&)[4][4]) const {} };

struct IdMap { __device__ __forceinline__ int operator()(int t) const { return t; } };
template <int NKC, class KS, class KD, class VS, class Fn, class TM = IdMap>
__device__ __forceinline__ void flash_loop(int tb, int te, KS ksrc, KD kdst, VS vsrc, u16* Ks, u16* Vs, Fn fn, TM tmap = IdMap()) {
  const int tid = TIDX();
  u32x4 rk[NKC], rv[2];
  if (tb < te) {
    const int tt = tmap(tb);
#pragma unroll
    for (int i = 0; i < NKC; ++i) rk[i] = *(GAS const u32x4*)ksrc(tt, tid + i * 256);
#pragma unroll
    for (int i = 0; i < 2; ++i) rv[i] = *(GAS const u32x4*)vsrc(tt, tid + i * 256);
  }
  for (int t = tb; t < te; ++t) {
    __syncthreads();
#pragma unroll
    for (int i = 0; i < NKC; ++i) *(u32x4*)(Ks + kdst(tid + i * 256)) = rk[i];
#pragma unroll
    for (int i = 0; i < 2; ++i) { int c = tid + i * 256; *(u32x4*)(Vs + (c >> 3) * 72 + (c & 7) * 8) = rv[i]; }
    __syncthreads();
    if (t + 1 < te) {
      const int tt = tmap(t + 1);
#pragma unroll
      for (int i = 0; i < NKC; ++i) rk[i] = *(GAS const u32x4*)ksrc(tt, tid + i * 256);
#pragma unroll
      for (int i = 0; i < 2; ++i) rv[i] = *(GAS const u32x4*)vsrc(tt, tid + i * 256);
    }
    fn(tmap(t));
  }
}

__device__ __forceinline__ void tr_tile(const float* __restrict__ src, int ldsrc, u16* __restrict__ dst, int K, int N,
                                        int kt, int nt, const float* __restrict__ scale, bool cmap, char* smem, int sklim = 1 << 30) {
  float* tile = (float*)smem;
  const int tid = TIDX();
  const int nn = tid & 63, np = nt * 64 + nn;
  int oc = np;
  if (cmap) { if (np >= 1024 && np < 3104) oc = np + 4; else if (np >= 3104 && np < 3108) oc = np - 2080; }
  const bool inr = np < N;
  const float* col = src + (inr ? oc : 0);
  const int k0 = kt * 64 + (tid >> 6);
  float vals[16];
#pragma unroll
  for (int i = 0; i < 16; ++i) vals[i] = col[(long)(k0 + i * 4) * ldsrc];
  if (scale) {
#pragma unroll
    for (int i = 0; i < 16; ++i) { const int k = k0 + i * 4; vals[i] *= (k < sklim) ? scale[k < sklim ? k : 0] : 1.f; }
  }
  __syncthreads();
#pragma unroll
  for (int i = 0; i < 16; ++i) tile[(i * 4 + (tid >> 6)) * 65 + nn] = inr ? vals[i] : 0.f;
  __syncthreads();
#pragma unroll 4
  for (int i = 0; i < 16; ++i) {
    int n2 = i * 4 + (tid >> 6), kk = tid & 63;
    dst[(long)(nt * 64 + n2) * K + kt * 64 + kk] = f2bf(tile[kk * 65 + n2]);
  }
}

constexpr int TR_ITEMS = 3448;
__device__ __forceinline__ void weights_item(const Params& p, int layer, int it, char* smem) {
  char* ws = WSP(p);
  if (it < 800) { tr_tile(INP(p, I_WIN) + (long)layer * 1024 * 3120, 3120, (u16*)(ws + OFF_WT_IN), 1024, 3120, it % 16, it / 16, nullptr, true, smem); return; }
  it -= 800;
  if (it < 256) { tr_tile(INP(p, I_WOUT) + (long)layer * 1024 * 1024, 1024, (u16*)(ws + OFF_WT_OUT), 1024, 1024, it % 16, it / 16, INP(p, I_SSMG) + layer * 256, false, smem, 256); return; }
  it -= 256;
  if (it < 1024) { tr_tile(INP(p, I_WM1) + (long)layer * 1024 * 4096, 4096, (u16*)(ws + OFF_WT_M1), 1024, 4096, it % 16, it / 16, nullptr, false, smem); return; }
  it -= 1024;
  if (it < 1024) { tr_tile(INP(p, I_WM2) + (long)layer * 4096 * 1024, 1024, (u16*)(ws + OFF_WT_M2), 4096, 1024, it % 64, it / 64, nullptr, false, smem); return; }
  it -= 1024;
  if (it < 24) { tr_tile(INP(p, I_WUQ) + (long)layer * 256 * 384, 384, (u16*)(ws + OFF_WT_UQ), 256, 384, it % 4, it / 4, INP(p, I_QNG) + layer * 256, false, smem); return; }
  it -= 24;
  if (it < 16) { tr_tile(INP(p, I_WUKV) + (long)layer * 128 * 512, 512, (u16*)(ws + OFF_WT_UKV), 128, 512, it % 2, it / 2, INP(p, I_KVNG) + layer * 128, false, smem); return; }
  it -= 16;
  if (it < 128) { tr_tile(INP(p, I_W1K) + (long)layer * 2048 * 256, 256, (u16*)(ws + OFF_WT_C1K), 2048, 256, it % 32, it / 32, nullptr, false, smem); return; }
  it -= 128;
  if (it < 128) { tr_tile(INP(p, I_W1V) + (long)layer * 2048 * 256, 256, (u16*)(ws + OFF_WT_C1V), 2048, 256, it % 32, it / 32, nullptr, false, smem); return; }
  it -= 128;
  if (it < 8) { tr_tile(INP(p, I_W2K) + (long)layer * 256 * 64, 64, (u16*)(ws + OFF_WT_C2K), 256, 64, it % 4, it / 4, nullptr, false, smem); return; }
  it -= 8;
  if (it < 8) { tr_tile(INP(p, I_W2V) + (long)layer * 256 * 64, 64, (u16*)(ws + OFF_WT_C2V), 256, 64, it % 4, it / 4, nullptr, false, smem); return; }
  it -= 8;
  {
    int job = it >> 4, sp = it & 15, n = TIDX();
    const float* pe = (job ? INP(p, I_PEV) : INP(p, I_PEK)) + (long)layer * 2048;
    const float* w1 = (job ? INP(p, I_W1V) : INP(p, I_W1K)) + (long)layer * 2048 * 256;
    float a = 0.f;
    for (int kk = sp * 128; kk < sp * 128 + 128; ++kk) a += pe[kk] * w1[(long)kk * 256 + n];
    ((float*)(ws + OFF_BIASP))[(job * 16 + sp) * 256 + n] = a;
  }
}

__device__ __forceinline__ void rope_item(const Params& p, int it) {
  const int tid = TIDX();
  const int pos = it * 16 + (tid >> 4), i = tid & 15;
  float* cm = (float*)(WSP(p) + OFF_COSM); float* sm = (float*)(WSP(p) + OFF_SINM);
  float* cr = (float*)(WSP(p) + OFF_COSR); float* sr = (float*)(WSP(p) + OFF_SINR);
  const float L2T = 13.287712379549449f;
  {
    float inv = exp2f(-(float)(2 * i) / 32.f * L2T);
    float ang = (float)pos * inv;
    double ad = (double)ang;
    float r = (float)(ad - 6.283185307179586 * rint(ad * 0.15915494309189535));
    cm[pos * 16 + i] = __cosf(r); sm[pos * 16 + i] = __sinf(r);
  }
#pragma unroll
  for (int e = 0; e < 2; ++e) {
    int ii = i + e * 16;
    float inv = exp2f(-(float)(2 * ii) / 64.f * L2T);
    float ang = (float)pos * inv;
    double ad = (double)ang;
    float r = (float)(ad - 6.283185307179586 * rint(ad * 0.15915494309189535));
    cr[pos * 32 + ii] = __cosf(r); sr[pos * 32 + ii] = __sinf(r);
  }
}

__device__ __forceinline__ void ln_row(const float* src, const float* __restrict__ g, const float* __restrict__ bb,
                                       float* dst32, u16* __restrict__ dstbf, int row, float* stats = nullptr) {
  const int lane = TIDX() & 63;
  const float4* s4 = (const float4*)(src + (long)row * 1024);
  float4 v[4];
#pragma unroll
  for (int i = 0; i < 4; ++i) v[i] = s4[lane + 64 * i];
  float sm = 0.f;
#pragma unroll
  for (int i = 0; i < 4; ++i) sm += v[i].x + v[i].y + v[i].z + v[i].w;
  const float mean = wave_sum(sm) * (1.f / 1024.f);
  float vs = 0.f;
#pragma unroll
  for (int i = 0; i < 4; ++i) {
    float a = v[i].x - mean, b = v[i].y - mean, c = v[i].z - mean, d = v[i].w - mean;
    vs += a * a + b * b + c * c + d * d;
  }
  const float rstd = rsqrtf(wave_sum(vs) * (1.f / 1024.f) + EPS_);
  float4* d4 = (float4*)(dst32 + (long)row * 1024);
  u32x2* db = (u32x2*)(dstbf + (long)row * 1024);
#pragma unroll
  for (int i = 0; i < 4; ++i) {
    float4 gg = ((const float4*)g)[lane + 64 * i], b4 = ((const float4*)bb)[lane + 64 * i], o;
    o.x = (v[i].x - mean) * rstd * gg.x + b4.x;
    o.y = (v[i].y - mean) * rstd * gg.y + b4.y;
    o.z = (v[i].z - mean) * rstd * gg.z + b4.z;
    o.w = (v[i].w - mean) * rstd * gg.w + b4.w;
    if (dst32) d4[lane + 64 * i] = o;
    u32x2 pk; pk.x = pack2(o.x, o.y); pk.y = pack2(o.z, o.w);
    db[lane + 64 * i] = pk;
  }
  if (stats && lane == 0) { stats[row * 2] = mean; stats[row * 2 + 1] = rstd; }
}

__device__ __forceinline__ void phase0(const Params& p, int bid, int nb, char* smem) {
  if (bid == 0 && TIDX() < 64) ((int*)(WSP(p) + OFF_CNT))[TIDX()] = 0;
  const int total = TR_ITEMS + 512 + 4096;
  for (int it = bid; it < total; it += nb) {
    if (it < TR_ITEMS) weights_item(p, 0, it, smem);
    else if (it < TR_ITEMS + 512) rope_item(p, it - TR_ITEMS);
    else {
      int row = (it - TR_ITEMS - 512) * 4 + (TIDX() >> 6);
      ln_row(INP(p, I_X), INP(p, I_LNEG), INP(p, I_LNEB), p.h32, (u16*)(WSP(p) + OFF_HBF), row);
    }
  }
}

__device__ __forceinline__ void phase_ln(const Params& p, int bid, int nb, char* smem, const float* g, const float* b, int conv_layer, int slot, bool final_out) {
  const int nconv = conv_layer >= 0 ? TR_ITEMS : 0;
  const int total = nconv + 4096;
  for (int it = bid; it < total; it += nb) {
    if (it < nconv) weights_item(p, conv_layer, it, smem);
    else {
      int row = (it - nconv) * 4 + (TIDX() >> 6);
      float* st = (float*)(WSP(p) + OFF_LNST) + (long)slot * T_ * 2;
      if (final_out) ln_row(p.h32, g, b, p.h32, (u16*)(WSP(p) + OFF_HBF), row);
      else ln_row(p.h32, g, b, nullptr, (u16*)(WSP(p) + OFF_HBF), row, st);
    }
  }
}

__device__ __forceinline__ int xcd_tile(int t, int bid, int nb, int ntiles) {
  if (nb & 7) return t;
  const int pass = t - bid;
  const int chunk = nb >> 3;
  const int r = (bid & 7) * chunk + (bid >> 3) + pass;
  return ((pass + nb) <= ntiles) ? r : t;
}

__device__ __forceinline__ void phase_inproj(const Params& p, int bid, int nb, char* smem) {
  const u16* A = (const u16*)(WSP(p) + OFF_HBF);
  const u16* Bt = (const u16*)(WSP(p) + OFF_WT_IN);
  u16* out = (u16*)(WSP(p) + OFF_R + R_PROJ);
  for (int t0 = bid; t0 < 128 * 25; t0 += nb) {
    const int t = xcd_tile(t0, bid, nb, 128 * 25);
    const int mt = t / 25, nt = t % 25;
    const int m0 = mt * 128, n0 = nt * 128;
    gemm_tile<true>([&](int r) { return A + (long)(m0 + r) * 1024; }, 64, Bt, 1024, 1024, n0,
              [&](int r, int c, const f32x4& v) {
                u32x2 pk; pk.x = pack2(v[0], v[1]); pk.y = pack2(v[2], v[3]);
                *(u32x2*)(out + (long)(m0 + r) * DINP_ + n0 + c) = pk;
              }, (u16*)smem);
  }
}

template <bool SSDNORM>
__device__ __forceinline__ void phase_resgemm(const Params& p, int bid, int nb, char* smem, const u16* A, int K, const u16* Bt,
                                              const float* lnst, const float* lng, const float* lnb) {
  float* h = p.h32;
  float* rstd = (float*)(smem + 65536);
  float* rowst = (float*)(smem + 65536 + 512);
  const float* ssq = (const float*)(WSP(p) + OFF_SSQ);
  for (int t0 = bid; t0 < 128 * 8; t0 += nb) {
    const int t = xcd_tile(t0, bid, nb, 128 * 8);
    const int mt = t / 8, nt = t % 8;
    const int m0 = mt * 128, n0 = nt * 128;
    if (SSDNORM) {
      __syncthreads();
      const int tid = TIDX();
      if (tid < 128) {
        const f32x4 s4 = *(const f32x4*)(ssq + (long)(m0 + tid) * 4);
        rstd[tid] = rsqrtf((s4[0] + s4[1] + s4[2] + s4[3]) * (1.f / 256.f) + EPS_);
      }
      __syncthreads();
    }
    if (lnst) {
      __syncthreads();
      const int tid = TIDX();
      rowst[tid] = lnst[(long)m0 * 2 + tid];
      __syncthreads();
    }
    gemm_tile<true>([&](int r) { return A + (long)(m0 + r) * K; }, 64, Bt, K, K, n0,
              [&](int r, int c, const f32x4& v) {
                f32x4* q = (f32x4*)(h + (long)(m0 + r) * 1024 + n0 + c);
                f32x4 res = *q;
                if (lnst) {
                  const float mu = rowst[r * 2], rs = rowst[r * 2 + 1];
                  const f32x4 g4 = *(const f32x4*)(lng + n0 + c), b4 = *(const f32x4*)(lnb + n0 + c);
                  res = (res - mu) * rs * g4 + b4;
                }
                *q = ALPHA_ * res + v;
              }, (u16*)smem,
              [&](int kt, f32x4 (&acc)[4][4]) {
                if (SSDNORM && kt == 3) {
                  const int tid = TIDX(), wm = tid >> 7, lr = tid & 15;
#pragma unroll
                  for (int mi = 0; mi < 4; ++mi) {
                    const float rs = rstd[wm * 64 + mi * 16 + lr];
#pragma unroll
                    for (int ni = 0; ni < 4; ++ni) acc[mi][ni] *= rs;
                  }
                }
              });
  }
}

__device__ __forceinline__ void phase_mlp1(const Params& p, int bid, int nb, char* smem) {
  const u16* A = (const u16*)(WSP(p) + OFF_HBF);
  const u16* Bt = (const u16*)(WSP(p) + OFF_WT_M1);
  u16* out = (u16*)(WSP(p) + OFF_R);
  for (int t0 = bid; t0 < 128 * 32; t0 += nb) {
    int mt, nt;
    if (nb == 512) {
      const int pass = t0 >> 9, x = bid & 7, j = bid >> 3;
      const int s = pass * 8 + x;
      mt = (s >> 2) * 8 + (j >> 3);
      nt = (s & 3) * 8 + (j & 7);
    } else {
      const int t = xcd_tile(t0, bid, nb, 128 * 32);
      mt = t / 32; nt = t % 32;
    }
    const int m0 = mt * 128, n0 = nt * 128;
    gemm_tile<true>([&](int r) { return A + (long)(m0 + r) * 1024; }, 64, Bt, 1024, 1024, n0,
              [&](int r, int c, const f32x4& v) {
                const float x0 = fmaxf(v[0], 0.f), x1 = fmaxf(v[1], 0.f), x2 = fmaxf(v[2], 0.f), x3 = fmaxf(v[3], 0.f);
                u32x2 pk; pk.x = pack2(x0 * x0, x1 * x1); pk.y = pack2(x2 * x2, x3 * x3);
                *(u32x2*)(out + (long)(m0 + r) * DFF_ + n0 + c) = pk;
              }, (u16*)smem);
  }
}

__device__ __forceinline__ void conv8(const u16* __restrict__ proj, const float* __restrict__ cw, const float* __restrict__ cb,
                                      int b, int pos, int ch0, float (&out)[8]) {
  float acc[8];
#pragma unroll
  for (int i = 0; i < 8; ++i) acc[i] = cb[ch0 + i];
  U8 v[4];
#pragma unroll
  for (int j = 0; j < 4; ++j) {
    const int pp = pos - 3 + j;
    v[j].u = *(const u32x4*)(proj + (long)(b * S_ + (pp > 0 ? pp : 0)) * DINP_ + C_XS + ch0);
  }
#pragma unroll
  for (int j = 0; j < 4; ++j) {
    const float mk = (pos - 3 + j) >= 0 ? 1.f : 0.f;
    const float* w = cw + j * 768 + ch0;
#pragma unroll
    for (int i = 0; i < 8; ++i) acc[i] += (w[i] * mk) * bf2f(v[j].s[i]);
  }
#pragma unroll
  for (int i = 0; i < 8; ++i) out[i] = silu_f(acc[i]);
}

__device__ __forceinline__ void ssd_dt_setup(const Params& p, int layer, int b, int c, int h, float* dtv, float* acs, float* tmp) {
  const int tid = TIDX(), lane = tid & 63;
  const u16* proj = PROJ(p);
  __syncthreads();
  float a = 0.f;
  if (tid < 128) {
    float raw = bf2f(proj[(long)(b * S_ + c * 128 + tid) * DINP_ + C_DT + h]) + INP(p, I_DTB)[layer * 4 + h];
    float dt = raw > 20.f ? raw : log1pf(__expf(raw));
    dtv[tid] = dt;
    a = -dt * __expf(INP(p, I_ALOG)[layer * 4 + h]);
#pragma unroll
    for (int ofs = 1; ofs < 64; ofs <<= 1) {
      const float v = __shfl_up(a, ofs);
      if (lane >= ofs) a += v;
    }
    if (tid == 63) tmp[0] = a;
  }
  __syncthreads();
  if (tid < 128) acs[tid] = (tid >= 64) ? a + tmp[0] : a;
  __syncthreads();
}

__device__ __forceinline__ void ssd_state_item(const Params& p, int layer, int item, char* smem) {
  const int b = item >> 8, c = (item >> 2) & 63, h = item & 3, g = h >> 1;
  const int tid = TIDX(), lane = tid & 63, wave = tid >> 6, lr = lane & 15, quad = lane >> 4;
  u16* Xt = (u16*)smem;
  u16* Btr = Xt + 64 * TSTR;
  float* dtv = (float*)(smem + (64 + 128) * TSTR * 2);
  float* acs = dtv + 128;
  float* tmp = acs + 128;
  const u16* proj = PROJ(p);
  const float* cw = INP(p, I_CONVW) + layer * 4 * 768;
  const float* cb = INP(p, I_CONVB) + layer * 768;
  ssd_dt_setup(p, layer, b, c, h, dtv, acs, tmp);
  const float aend = acs[127];
#pragma unroll 2
  for (int i = 0; i < 4; ++i) {
    int cc = tid + i * 256, l = cc >> 3, p0 = (cc & 7) * 8;
    float o[8];
    conv8(proj, cw, cb, b, c * 128 + l, h * 64 + p0, o);
    const float w = dtv[l] * __expf(aend - acs[l]);
#pragma unroll
    for (int e = 0; e < 8; ++e) Xt[(p0 + e) * TSTR + l] = f2bf(o[e] * w);
  }
#pragma unroll 2
  for (int i = 0; i < 8; ++i) {
    int cc = tid + i * 256, l = cc >> 4, n0 = (cc & 15) * 8;
    float o[8];
    conv8(proj, cw, cb, b, c * 128 + l, 256 + g * 128 + n0, o);
#pragma unroll
    for (int e = 0; e < 8; ++e) Btr[(n0 + e) * TSTR + l] = f2bf(o[e]);
  }
  __syncthreads();
  f32x4 acc[4][2];
#pragma unroll
  for (int mi = 0; mi < 4; ++mi) { acc[mi][0] = (f32x4){0.f, 0.f, 0.f, 0.f}; acc[mi][1] = (f32x4){0.f, 0.f, 0.f, 0.f}; }
#pragma unroll
  for (int ks = 0; ks < 4; ++ks) {
    bf16x8 bb[2];
#pragma unroll
    for (int ni = 0; ni < 2; ++ni) bb[ni] = *(const bf16x8*)(Btr + (wave * 32 + ni * 16 + lr) * TSTR + ks * 32 + quad * 8);
#pragma unroll
    for (int mi = 0; mi < 4; ++mi) {
      bf16x8 a = *(const bf16x8*)(Xt + (mi * 16 + lr) * TSTR + ks * 32 + quad * 8);
      acc[mi][0] = MFMA(a, bb[0], acc[mi][0]);
      acc[mi][1] = MFMA(a, bb[1], acc[mi][1]);
    }
  }
  float* st = (float*)(WSP(p) + OFF_R + R_SSDST) + (long)((b * 64 + c) * 4 + h) * 8192;
#pragma unroll
  for (int mi = 0; mi < 4; ++mi)
#pragma unroll
    for (int ni = 0; ni < 2; ++ni)
#pragma unroll
      for (int j = 0; j < 4; ++j) st[(mi * 16 + quad * 4 + j) * 128 + wave * 32 + ni * 16 + lr] = acc[mi][ni][j];
  if (tid == 0) ((float*)(WSP(p) + OFF_SSDDEC))[(b * 64 + c) * 4 + h] = __expf(aend);
}

__device__ __forceinline__ void ret_rope8(const Params& p, const u16* __restrict__ proj, int col, int b, int pos, int d0, float scale, float (&out)[8]) {
  const u16* row = proj + (long)(b * S_ + pos) * DINP_ + col;
  const int i0 = d0 & 31;
  U8 x1, x2;
  x1.u = *(const u32x4*)(row + i0);
  x2.u = *(const u32x4*)(row + 32 + i0);
  const float* cr = (const float*)(WSP(p) + OFF_COSR) + pos * 32 + i0;
  const float* sr = (const float*)(WSP(p) + OFF_SINR) + pos * 32 + i0;
#pragma unroll
  for (int e = 0; e < 8; ++e) {
    float a = bf2f(x1.s[e]), bb = bf2f(x2.s[e]), cc = cr[e], ss = sr[e];
    out[e] = (d0 < 32 ? (a * cc - bb * ss) : (a * ss + bb * cc)) * scale;
  }
}

__device__ __forceinline__ float ret_loggamma(int h) { return log1pf(-exp2f(-5.f - (float)h)); }

__device__ __forceinline__ void ret_state_item(const Params& p, int layer, int item, char* smem) {
  const int b = item >> 8, c = (item >> 2) & 63, h = item & 3;
  const int tid = TIDX(), lane = tid & 63, wave = tid >> 6, lr = lane & 15, quad = lane >> 4;
  u16* Vt = (u16*)smem;
  u16* Kt = Vt + 64 * TSTR;
  const u16* proj = PROJ(p);
  const float lg = ret_loggamma(h);
  __syncthreads();
#pragma unroll 2
  for (int i = 0; i < 4; ++i) {
    int cc = tid + i * 256, l = cc >> 3, v0 = (cc & 7) * 8;
    U8 x; x.u = *(const u32x4*)(proj + (long)(b * S_ + c * 128 + l) * DINP_ + C_RV + h * 64 + v0);
    const float z = __expf((float)(127 - l) * lg);
#pragma unroll
    for (int e = 0; e < 8; ++e) Vt[(v0 + e) * TSTR + l] = f2bf(bf2f(x.s[e]) * z);
  }
#pragma unroll 2
  for (int i = 0; i < 4; ++i) {
    int cc = tid + i * 256, l = cc >> 3, d0 = (cc & 7) * 8;
    float o[8];
    ret_rope8(p, proj, C_RK + h * 64, b, c * 128 + l, d0, 0.125f, o);
#pragma unroll
    for (int e = 0; e < 8; ++e) Kt[(d0 + e) * TSTR + l] = f2bf(o[e]);
  }
  __syncthreads();
  f32x4 acc[4];
#pragma unroll
  for (int mi = 0; mi < 4; ++mi) acc[mi] = (f32x4){0.f, 0.f, 0.f, 0.f};
#pragma unroll
  for (int ks = 0; ks < 4; ++ks) {
    bf16x8 bb = *(const bf16x8*)(Kt + (wave * 16 + lr) * TSTR + ks * 32 + quad * 8);
#pragma unroll
    for (int mi = 0; mi < 4; ++mi) {
      bf16x8 a = *(const bf16x8*)(Vt + (mi * 16 + lr) * TSTR + ks * 32 + quad * 8);
      acc[mi] = MFMA(a, bb, acc[mi]);
    }
  }
  float* st = (float*)(WSP(p) + OFF_R + R_RETST) + (long)((b * 64 + c) * 4 + h) * 4096;
#pragma unroll
  for (int mi = 0; mi < 4; ++mi)
#pragma unroll
    for (int j = 0; j < 4; ++j) st[(mi * 16 + quad * 4 + j) * 64 + wave * 16 + lr] = acc[mi][j];
}

__device__ __forceinline__ void mla_up_item(const Params& p, int which, int t, char* smem) {
  const int tid = TIDX();
  const u16* proj = PROJ(p);
  float* rstd = (float*)(smem + 65536);
  const int K = which ? 128 : 256, nnt = which ? 4 : 3;
  const int mt = t / nnt, nt = t % nnt, m0 = mt * 128, n0 = nt * 128;
  const int col = which ? C_CKV : C_CQ;
  __syncthreads();
  {
    const int r = tid >> 1, hf = tid & 1, n = K / 2;
    const u16* src = proj + (long)(m0 + r) * DINP_ + col + hf * n;
    float ss = 0.f;
    for (int i = 0; i < n; i += 8) {
      U8 x; x.u = *(const u32x4*)(src + i);
#pragma unroll
      for (int e = 0; e < 8; ++e) { float f = bf2f(x.s[e]); ss += f * f; }
    }
    ss += __shfl_xor(ss, 1);
    if (hf == 0) rstd[r] = rsqrtf(ss / (float)K + EPS_);
  }
  __syncthreads();
  if (which == 0) {
    u16* q = (u16*)(WSP(p) + OFF_QMLA);
    const float sc = 0.10206207261596575f * 1.4426950408889634f;
    gemm_tile<true>([&](int r) { return proj + (long)(m0 + r) * DINP_ + col; }, 64, (const u16*)(WSP(p) + OFF_WT_UQ), 256, 256, n0,
              [&](int r, int c, const f32x4& v) {
                const float rs = rstd[r] * sc;
                u32x2 pk; pk.x = pack2(v[0] * rs, v[1] * rs); pk.y = pack2(v[2] * rs, v[3] * rs);
                *(u32x2*)(q + (long)(m0 + r) * 384 + n0 + c) = pk;
              }, (u16*)smem);
  } else {
    u16* kb = (u16*)(WSP(p) + OFF_KBUF);
    u16* vt = (u16*)(WSP(p) + OFF_VTMLA);
    gemm_tile<false>([&](int r) { return proj + (long)(m0 + r) * DINP_ + col; }, 64, (const u16*)(WSP(p) + OFF_WT_UKV), 128, 128, n0,
              [&](int r, int c, const f32x4& v) {
                const int n = n0 + c, hh = n >> 7, d = n & 127;
                if (d < 64) {
#pragma unroll
                  for (int j = 0; j < 4; ++j) kb[(long)(m0 + r + j) * 384 + hh * 96 + d] = f2bf(v[j] * rstd[r + j]);
                } else {
                  const int tok = m0 + r, bb = tok >> 13, pos = tok & 8191;
                  u32x2 pk;
                  pk.x = pack2(v[0] * rstd[r], v[1] * rstd[r + 1]);
                  pk.y = pack2(v[2] * rstd[r + 2], v[3] * rstd[r + 3]);
                  *(u32x2*)(vt + ((long)(bb * 4 + hh) * 64 + (d - 64)) * 8192 + pos) = pk;
                }
              }, (u16*)smem);
  }
}

__device__ __forceinline__ void kpe_item(const Params& p, int it) {
  const int tid = TIDX();
  const u16* proj = PROJ(p);
  u16* kb = (u16*)(WSP(p) + OFF_KBUF);
  const float* cm = (const float*)(WSP(p) + OFF_COSM);
  const float* sm = (const float*)(WSP(p) + OFF_SINM);
#pragma unroll 4
  for (int e = 0; e < 8; ++e) {
    int idx = tid + e * 256;
    int tok = it * 128 + (idx >> 4), i = idx & 15, pos = tok & 8191;
    const u16* row = proj + (long)tok * DINP_ + C_KR;
    float x1 = bf2f(row[i]), x2 = bf2f(row[16 + i]);
    float c = cm[pos * 16 + i], s = sm[pos * 16 + i];
    u16 y1 = f2bf(x1 * c - x2 * s), y2 = f2bf(x1 * s + x2 * c);
#pragma unroll
    for (int hh = 0; hh < 4; ++hh) { kb[(long)tok * 384 + hh * 96 + 64 + i] = y1; kb[(long)tok * 384 + hh * 96 + 80 + i] = y2; }
  }
}

__device__ __forceinline__ void vtrans_item(const Params& p, int it, char* smem) {
  const int which = it >> 8, blk = it & 255, b = blk >> 7, t0 = (blk & 127) * 64;
  const int tid = TIDX();
  const u16* proj = PROJ(p);
  u16* tile = (u16*)smem;
  u16* dst = (u16*)(WSP(p) + (which ? OFF_VWT : OFF_VST));
  const int col = which ? C_NVW : C_NVS;
  __syncthreads();
#pragma unroll
  for (int i = 0; i < 2; ++i) {
    int c = tid + i * 256, tok = c >> 3, ch = c & 7;
    *(u32x4*)(tile + tok * 72 + ch * 8) = *(const u32x4*)(proj + (long)(b * S_ + t0 + tok) * DINP_ + col + ch * 8);
  }
  __syncthreads();
#pragma unroll
  for (int i = 0; i < 2; ++i) {
    int c = tid + i * 256, d = c >> 3, tch = c & 7;
    U8 o;
#pragma unroll
    for (int e = 0; e < 8; ++e) o.s[e] = tile[(tch * 8 + e) * 72 + d];
    *(u32x4*)(dst + (long)(b * 64 + d) * 8192 + t0 + tch * 8) = o.u;
  }
}

__device__ __forceinline__ void cmp_hid_item(const Params& p, int t, char* smem) {
  const int job = t >> 4, mt = (t >> 1) & 7, nt = t & 1, m0 = mt * 128, n0 = nt * 128;
  const u16* proj = PROJ(p);
  const int col = job ? C_NVC : C_NKC;
  u16* hid = (u16*)(WSP(p) + OFF_R + R_HID) + (long)job * 1024 * 256;
  const float* bp = (const float*)(WSP(p) + OFF_BIASP) + job * 16 * 256;
  float* bl = (float*)(smem + 65536);
  __syncthreads();
  if (TIDX() < 128) {
    float bias = 0.f;
#pragma unroll
    for (int s = 0; s < 16; ++s) bias += bp[s * 256 + n0 + TIDX()];
    bl[TIDX()] = bias;
  }
  __syncthreads();
  gemm_tile<true>([&](int r) { int rr = m0 + r; return proj + (long)((rr >> 9) * S_ + (rr & 511) * 16) * DINP_ + col; }, DINP_,
            (const u16*)(WSP(p) + (job ? OFF_WT_C1V : OFF_WT_C1K)), 2048, 2048, n0,
            [&](int r, int c, const f32x4& v) {
              const f32x4 b4 = *(const f32x4*)(bl + c);
              u32x2 pk;
              pk.x = pack2(silu_f(v[0] + b4[0]), silu_f(v[1] + b4[1]));
              pk.y = pack2(silu_f(v[2] + b4[2]), silu_f(v[3] + b4[3]));
              *(u32x2*)(hid + (long)(m0 + r) * 256 + n0 + c) = pk;
            }, (u16*)smem);
}

__device__ __forceinline__ int next_item_xcd(int* cnt8, int per, int& qx, char* smem) {
  int* sh = (int*)(smem + SMEM_BYTES - 16);
  __syncthreads();
  if (TIDX() == 0) {
    int res = -1;
    const int x0 = (int)blockIdx.x & 7;
    for (int s = 0; s < 8; ++s) {
      const int x = (x0 + s) & 7;
      const int d = atomicAdd(cnt8 + x, 1);
      if (d < per) { res = x * 65536 + d; break; }
    }
    *sh = res;
  }
  __syncthreads();
  const int r = *sh;
  qx = r >> 16;
  return r < 0 ? -1 : (r & 65535);
}
#define QLOOP_X(C8, PER, CALL)                                            \
  for (;;) {                                                              \
    int qx;                                                               \
    const int qd = next_item_xcd(cnt + (C8), (PER), qx, smem);            \
    if (qd < 0) break;                                                    \
    CALL;                                                                 \
  }
#define QLOOP(CIDX, N, CALL)                                              \
  for (;;) {                                                              \
    const int it = next_item(cnt + (CIDX), smem);                         \
    if (it >= (N)) break;                                                 \
    CALL;                                                                 \
  }
__device__ __forceinline__ void phase2(const Params& p, int layer, char* smem) {
  int* cnt = (int*)(WSP(p) + OFF_CNT) + layer * 16;
  QLOOP(0, 32, cmp_hid_item(p, it, smem))
  QLOOP(1, 512, ssd_state_item(p, layer, it, smem))
  QLOOP(2, 512, ret_state_item(p, layer, it, smem))
  QLOOP(3, 384, mla_up_item(p, 0, it, smem))
  QLOOP(4, 512, mla_up_item(p, 1, it, smem))
  QLOOP(5, 128, kpe_item(p, it))
  QLOOP(6, 512, vtrans_item(p, it, smem))
}


struct MlaTab { unsigned char qb[160], c[160]; };
constexpr MlaTab make_mla_tab() {
  MlaTab t{};
  int n = 0;
  for (int qb = 63; qb >= 0; --qb) { const int nt = 2 * qb + 2; for (int c = 0; c < nt / 32; ++c) { t.qb[n] = (unsigned char)qb; t.c[n] = (unsigned char)c; ++n; } }
  for (int rem = 30; rem >= 2; rem -= 2)
    for (int qb = 63; qb >= 0; --qb) { const int nt = 2 * qb + 2; if (nt % 32 == rem) { t.qb[n] = (unsigned char)qb; t.c[n] = (unsigned char)(nt / 32); ++n; } }
  return t;
}
__device__ const MlaTab g_mla_tab = make_mla_tab();
__device__ __forceinline__ int mla_slot(int bh, int qb, int c) { const int k = qb >> 4, r = qb & 15; return bh * 160 + 8 * k * (k + 1) + r * (k + 1) + c; }

__device__ __forceinline__ void mla_item(const Params& p, int item, char* smem) {
  const int un = item >> 3, bh = item & 7, b = bh >> 2, h = bh & 3;
  const int qb = g_mla_tab.qb[un], ch = g_mla_tab.c[un];
  const int tid = TIDX(), lane = tid & 63, wave = tid >> 6, lr = lane & 15, quad = lane >> 4;
  u16* Ks = (u16*)smem;
  u16* Vs = Ks + 64 * 104;
  const u16* qm = (const u16*)(WSP(p) + OFF_QMLA);
  const u16* kb = (const u16*)(WSP(p) + OFF_KBUF);
  const u16* vt = (const u16*)(WSP(p) + OFF_VTMLA) + (long)(b * 4 + h) * 64 * 8192;
  const float* cm = (const float*)(WSP(p) + OFF_COSM);
  const float* sm = (const float*)(WSP(p) + OFF_SINM);
  int tq[2];
  bf16x8 qf[3][2];
#pragma unroll
  for (int qt = 0; qt < 2; ++qt) {
    tq[qt] = qb * 128 + wave * 32 + qt * 16 + lr;
    const u16* qrow = qm + (long)(b * S_ + tq[qt]) * 384 + h * 96;
    qf[0][qt] = *(const bf16x8*)(qrow + quad * 8);
    qf[1][qt] = *(const bf16x8*)(qrow + 32 + quad * 8);
    U8 x, xp, o;
    x.u = *(const u32x4*)(qrow + 64 + quad * 8);
    xp.u = *(const u32x4*)(qrow + 64 + (quad ^ 2) * 8);
    const int i0 = (quad & 1) * 8;
#pragma unroll
    for (int e = 0; e < 8; ++e) {
      float c = cm[tq[qt] * 16 + i0 + e], s = sm[tq[qt] * 16 + i0 + e];
      float a = bf2f(x.s[e]), bb = bf2f(xp.s[e]);
      o.s[e] = f2bf(quad < 2 ? (a * c - bb * s) : (bb * s + a * c));
    }
    qf[2][qt] = o.v;
  }
  f32x4 o[4][2];
#pragma unroll
  for (int dt = 0; dt < 4; ++dt) { o[dt][0] = (f32x4){0.f, 0.f, 0.f, 0.f}; o[dt][1] = (f32x4){0.f, 0.f, 0.f, 0.f}; }
  float m[2] = {-1e30f, -1e30f}, l[2] = {0.f, 0.f};
  const int nt = 2 * qb + 2, nch = (nt + 31) >> 5;
  const int tb = ch * 32, te = (tb + 32 < nt) ? tb + 32 : nt;
  auto kf = [&](int kt, int ks) { return *(const bf16x8*)(Ks + (kt * 16 + lr) * 104 + ks * 32 + quad * 8); };
  auto vf = [&](int dt, int kk) {
    U8 u;
    u.d[0] = *(const u64*)(Vs + (dt * 16 + lr) * 72 + kk * 32 + quad * 4);
    u.d[1] = *(const u64*)(Vs + (dt * 16 + lr) * 72 + kk * 32 + 16 + quad * 4);
    return u.v;
  };
  flash_loop<3>(tb, te,
      [&](int t, int c) { int key = c / 12, cc = c % 12; return kb + (long)(b * S_ + t * 64 + key) * 384 + h * 96 + cc * 8; },
      [&](int c) { int key = c / 12, cc = c % 12; return key * 104 + cc * 8; },
      [&](int t, int c) { return vt + (long)(c >> 3) * 8192 + t * 64 + (c & 7) * 8; },
      Ks, Vs,
      [&](int t) {
        if (t == nt - 1 && wave < 2) return;
        const float sh0 = ft_shift(m[0]), sh1 = ft_shift(m[1]);
        if (t >= nt - 2) {
          const int lim0 = tq[0] - t * 64 - quad * 4, lim1 = tq[1] - t * 64 - quad * 4;
          flash_tile2<3, true>(kf, vf, [=](int qt, int kt) {
            const int lim = qt ? lim1 : lim0;
            const float sh = qt ? sh1 : sh0;
            f32x4 c;
#pragma unroll
            for (int j = 0; j < 4; ++j) c[j] = (kt * 16 + j <= lim) ? sh : -INFINITY;
            return c;
          }, NoHook(), qf, o, m, l);
        } else {
          flash_tile2<3, true>(kf, vf, [=](int qt, int) { const float sh = qt ? sh1 : sh0; return (f32x4){sh, sh, sh, sh}; }, NoHook(), qf, o, m, l);
        }
      });
  u16* mix = (u16*)(WSP(p) + OFF_HBF);
  const int slot = mla_slot(bh, qb, ch);
  u16* pO = (u16*)(WSP(p) + OFF_MLAP) + (long)slot * 8192;
  float* pML = (float*)(WSP(p) + OFF_MLAML) + (long)slot * 256;
#pragma unroll
  for (int qt = 0; qt < 2; ++qt) {
    float lt = l[qt];
    lt += __shfl_xor(lt, 16);
    lt += __shfl_xor(lt, 32);
    const float inv = 1.f / lt;
    const int ql = wave * 32 + qt * 16 + lr;
    u16* orow = (nch == 1) ? mix + (long)(b * S_ + tq[qt]) * 1024 + 256 + h * 64 : pO + ql * 64;
#pragma unroll
    for (int dt = 0; dt < 4; ++dt) {
      u32x2 pk;
      pk.x = pack2(o[dt][qt][0] * inv, o[dt][qt][1] * inv);
      pk.y = pack2(o[dt][qt][2] * inv, o[dt][qt][3] * inv);
      *(u32x2*)(orow + dt * 16 + quad * 4) = pk;
    }
    if (nch > 1 && quad == 0) { pML[ql * 2] = m[qt]; pML[ql * 2 + 1] = lt; }
  }
}

__device__ __forceinline__ void mla_combine_item(const Params& p, int ci) {
  const int bh = ci & 7, qb = 63 - (ci >> 3), b = bh >> 2, h = bh & 3;
  const int nch = (2 * qb + 2 + 31) >> 5;
  const int tid = TIDX(), q = tid >> 1, hf = tid & 1;
  const int slot0 = mla_slot(bh, qb, 0);
  const u16* pO = (const u16*)(WSP(p) + OFF_MLAP) + (long)slot0 * 8192 + q * 64 + hf * 32;
  const float* pML = (const float*)(WSP(p) + OFF_MLAML) + (long)slot0 * 256 + q * 2;
  float mc[4], lc[4], M = -1e30f;
#pragma unroll
  for (int c = 0; c < 4; ++c) {
    mc[c] = -1e30f; lc[c] = 0.f;
    if (c < nch) { mc[c] = pML[c * 256]; lc[c] = pML[c * 256 + 1]; }
    M = fmaxf(M, mc[c]);
  }
  float w[4], W = 0.f;
#pragma unroll
  for (int c = 0; c < 4; ++c) { w[c] = (c < nch) ? __builtin_amdgcn_exp2f(mc[c] - M) * lc[c] : 0.f; W += w[c]; }
  const float iW = 1.f / W;
  float acc[32];
#pragma unroll
  for (int e = 0; e < 32; ++e) acc[e] = 0.f;
#pragma unroll
  for (int c = 0; c < 4; ++c) {
    if (c < nch) {
      const float wc = w[c] * iW;
#pragma unroll
      for (int g = 0; g < 4; ++g) {
        U8 x; x.u = *(const u32x4*)(pO + (long)c * 8192 + g * 8);
#pragma unroll
        for (int e = 0; e < 8; ++e) acc[g * 8 + e] += wc * bf2f(x.s[e]);
      }
    }
  }
  u16* orow = (u16*)(WSP(p) + OFF_HBF) + (long)(b * S_ + qb * 128 + q) * 1024 + 256 + h * 64 + hf * 32;
#pragma unroll
  for (int g = 0; g < 4; ++g) {
    U8 o;
#pragma unroll
    for (int e = 0; e < 4; ++e) o.w[e] = pack2(acc[g * 8 + 2 * e], acc[g * 8 + 2 * e + 1]);
    *(u32x4*)(orow + g * 8) = o.u;
  }
}

__device__ __forceinline__ void cmp_out_item(const Params& p, int t, char* smem) {
  const int job = t >> 3, mt = t & 7, m0 = mt * 128;
  const u16* hid = (const u16*)(WSP(p) + OFF_R + R_HID) + (long)job * 1024 * 256;
  u16* kc = (u16*)(WSP(p) + OFF_R + R_KCMP);
  u16* vct = (u16*)(WSP(p) + OFF_R + R_VCT);
  gemm_tile<false>([&](int r) { return hid + (long)(m0 + r) * 256; }, 64, (const u16*)(WSP(p) + (job ? OFF_WT_C2V : OFF_WT_C2K)), 256, 256, 0,
            [&](int r, int c, const f32x4& v) {
              if (c < 64) {
                if (job == 0) {
#pragma unroll
                  for (int j = 0; j < 4; ++j) kc[(long)(m0 + r + j) * 64 + c] = f2bf(v[j]);
                } else {
                  const int rr = m0 + r, bb = rr >> 9, i = rr & 511;
                  u32x2 pk; pk.x = pack2(v[0], v[1]); pk.y = pack2(v[2], v[3]);
                  *(u32x2*)(vct + (long)(bb * 64 + c) * 512 + i) = pk;
                }
              }
            }, (u16*)smem);
}

__device__ __forceinline__ void scan_item(const Params& p, int it) {
  const int tid = TIDX();
  if (it < 256) {
    const int e = it * 256 + tid, b = e >> 15, h = (e >> 13) & 3, pn = e & 8191;
    float* st = (float*)(WSP(p) + OFF_R + R_SSDST) + (long)(b * 64 * 4 + h) * 8192 + pn;
    const float* dec = (const float*)(WSP(p) + OFF_SSDDEC) + b * 64 * 4 + h;
    float run = 0.f;
#pragma unroll 1
    for (int c0 = 0; c0 < 64; c0 += 16) {
      float s[16], d[16];
#pragma unroll
      for (int i = 0; i < 16; ++i) { s[i] = st[(long)(c0 + i) * 4 * 8192]; d[i] = dec[(c0 + i) * 4]; }
#pragma unroll
      for (int i = 0; i < 16; ++i) { const float prev = run; run = run * d[i] + s[i]; s[i] = prev; }
#pragma unroll
      for (int i = 0; i < 16; ++i) st[(long)(c0 + i) * 4 * 8192] = s[i];
    }
  } else {
    const int e = (it - 256) * 256 + tid, b = e >> 14, h = (e >> 12) & 3, vd = e & 4095;
    float* st = (float*)(WSP(p) + OFF_R + R_RETST) + (long)(b * 64 * 4 + h) * 4096 + vd;
    const float d = __expf(128.f * ret_loggamma(h));
    float run = 0.f;
#pragma unroll 1
    for (int c0 = 0; c0 < 64; c0 += 16) {
      float s[16];
#pragma unroll
      for (int i = 0; i < 16; ++i) s[i] = st[(long)(c0 + i) * 4 * 4096];
#pragma unroll
      for (int i = 0; i < 16; ++i) { const float prev = run; run = run * d + s[i]; s[i] = prev; }
#pragma unroll
      for (int i = 0; i < 16; ++i) st[(long)(c0 + i) * 4 * 4096] = s[i];
    }
  }
}

__device__ __forceinline__ void phase3(const Params& p, int layer, char* smem) {
  int* cnt = (int*)(WSP(p) + OFF_CNT) + layer * 16;
  QLOOP(7, 1280, mla_item(p, it, smem))
  QLOOP(8, 16, cmp_out_item(p, it, smem))
  QLOOP(9, 384, scan_item(p, it))
}

__device__ __forceinline__ void ssd_out_item(const Params& p, int layer, int item, char* smem) {
  const int b = item >> 8, c = (item >> 2) & 63, h = item & 3;
  const int tid = TIDX(), lane = tid & 63, wave = tid >> 6, lr = lane & 15, quad = lane >> 4;
  u16* Bs = (u16*)smem;
  u16* Xt = Bs + 128 * TSTR;
  u16* Sc = Xt + 64 * TSTR;
  float* dtv = (float*)(smem + (128 + 64 + 64) * TSTR * 2);
  float* acs = dtv + 128;
  float* tmp = acs + 128;
  float* ssq = tmp + 128;
  const u16* proj = PROJ(p);
  u16* mix = (u16*)(WSP(p) + OFF_HBF);
  const float* cw = INP(p, I_CONVW) + layer * 4 * 768;
  const float* cb = INP(p, I_CONVB) + layer * 768;
  float* ssqg = (float*)(WSP(p) + OFF_SSQ);
  (void)ssq;
  {
    const int g = h >> 1;
    ssd_dt_setup(p, layer, b, c, h, dtv, acs, tmp);
#pragma unroll 2
    for (int i = 0; i < 8; ++i) {
      int cc = tid + i * 256, l = cc >> 4, n0 = (cc & 15) * 8;
      float o[8];
      conv8(proj, cw, cb, b, c * 128 + l, 256 + g * 128 + n0, o);
      U8 u;
#pragma unroll
      for (int e = 0; e < 4; ++e) u.w[e] = pack2(o[2 * e], o[2 * e + 1]);
      *(u32x4*)(Bs + l * TSTR + n0) = u.u;
    }
#pragma unroll 2
    for (int i = 0; i < 4; ++i) {
      int cc = tid + i * 256, l = cc >> 3, p0 = (cc & 7) * 8;
      float o[8];
      conv8(proj, cw, cb, b, c * 128 + l, h * 64 + p0, o);
#pragma unroll
      for (int e = 0; e < 8; ++e) Xt[(p0 + e) * TSTR + l] = f2bf(o[e]);
    }
    __syncthreads();
    const float dsk = INP(p, I_DSKIP)[layer * 4 + h];
    const float* prev = (const float*)(WSP(p) + OFF_R + R_SSDST) + (long)((b * 64 + c) * 4 + h) * 8192;
#pragma unroll 1
    for (int pass = 0; pass < 2; ++pass) {
      const int row0 = pass * 64 + wave * 16;
      const int nlim = pass * 4 + wave + 1;
      bf16x8 cf[4];
#pragma unroll
      for (int ks = 0; ks < 4; ++ks) {
        float o[8];
        conv8(proj, cw, cb, b, c * 128 + row0 + lr, 512 + g * 128 + ks * 32 + quad * 8, o);
        U8 u;
#pragma unroll
        for (int e = 0; e < 4; ++e) u.w[e] = pack2(o[2 * e], o[2 * e + 1]);
        cf[ks] = u.v;
      }
#pragma unroll
      for (int ni = 0; ni < 8; ++ni) {
        if (ni < nlim) {
          f32x4 ga = (f32x4){0.f, 0.f, 0.f, 0.f};
#pragma unroll
          for (int ks = 0; ks < 4; ++ks) {
            bf16x8 bb = *(const bf16x8*)(Bs + (ni * 16 + lr) * TSTR + ks * 32 + quad * 8);
            ga = MFMA(cf[ks], bb, ga);
          }
          const int s = ni * 16 + lr;
          const float as = acs[s], ds = dtv[s];
#pragma unroll
          for (int j = 0; j < 4; ++j) {
            const int l = row0 + quad * 4 + j;
            float v = (s <= l) ? ga[j] * __expf(acs[l] - as) * ds : 0.f;
            Sc[(wave * 16 + quad * 4 + j) * TSTR + s] = f2bf(v);
          }
        } else if (ni == nlim) {
#pragma unroll
          for (int j = 0; j < 4; ++j) Sc[(wave * 16 + quad * 4 + j) * TSTR + ni * 16 + lr] = 0;
        }
      }
      f32x4 y[4];
#pragma unroll
      for (int ni = 0; ni < 4; ++ni) y[ni] = (f32x4){0.f, 0.f, 0.f, 0.f};
#pragma unroll
      for (int ks = 0; ks < 4; ++ks)
#pragma unroll
        for (int ni = 0; ni < 4; ++ni) {
          const float4* pp = (const float4*)(prev + (ni * 16 + lr) * 128 + ks * 32 + quad * 8);
          float4 f0 = pp[0], f1 = pp[1];
          U8 u;
          u.w[0] = pack2(f0.x, f0.y); u.w[1] = pack2(f0.z, f0.w); u.w[2] = pack2(f1.x, f1.y); u.w[3] = pack2(f1.z, f1.w);
          y[ni] = MFMA(cf[ks], u.v, y[ni]);
        }
#pragma unroll
      for (int j = 0; j < 4; ++j) {
        const float e = __expf(acs[row0 + quad * 4 + j]);
#pragma unroll
        for (int ni = 0; ni < 4; ++ni) y[ni][j] *= e;
      }
      asm volatile("s_waitcnt lgkmcnt(0)" ::: "memory");
#pragma unroll
      for (int ks = 0; ks < 4; ++ks) {
        if (ks * 2 < nlim) {
          bf16x8 a0 = *(const bf16x8*)(Sc + (wave * 16 + lr) * TSTR + ks * 32 + quad * 8);
#pragma unroll
          for (int ni = 0; ni < 4; ++ni) {
            bf16x8 bb = *(const bf16x8*)(Xt + (ni * 16 + lr) * TSTR + ks * 32 + quad * 8);
            y[ni] = MFMA(a0, bb, y[ni]);
          }
        }
      }
#pragma unroll
      for (int j = 0; j < 4; ++j) {
        const int l = row0 + quad * 4 + j;
        const long tok = (long)b * S_ + c * 128 + l;
        float sq = 0.f;
#pragma unroll
        for (int ni = 0; ni < 4; ++ni) {
          const int pp = ni * 16 + lr;
          float yv = y[ni][j] + bf2f(Xt[pp * TSTR + l]) * dsk;
          yv *= silu_f(bf2f(proj[tok * DINP_ + C_Z + h * 64 + pp]));
          const u16 yb = f2bf(yv);
          const float yr = bf2f(yb);
          sq += yr * yr;
          mix[tok * 1024 + h * 64 + pp] = yb;
        }
        sq += __shfl_xor(sq, 1); sq += __shfl_xor(sq, 2); sq += __shfl_xor(sq, 4); sq += __shfl_xor(sq, 8);
        if (lr == 0) ssqg[tok * 4 + h] = sq;
      }
    }
  }
#if 0
  const float* gn = INP(p, I_SSMG) + layer * 256;
#pragma unroll 1
  for (int i = 0; i < 16; ++i) {
    int cc = tid + i * 256, l = cc >> 5, c0 = (cc & 31) * 8;
    const float rs = rsqrtf(ssq[l] * (1.f / 256.f) + EPS_);
    u64* ptr = (u64*)(mix + ((long)b * S_ + c * 128 + l) * 1024 + c0);
    U8 x;
    x.d[0] = __hip_atomic_load(ptr, __ATOMIC_RELAXED, __HIP_MEMORY_SCOPE_AGENT);
    x.d[1] = __hip_atomic_load(ptr + 1, __ATOMIC_RELAXED, __HIP_MEMORY_SCOPE_AGENT);
    U8 o;
#pragma unroll
    for (int e = 0; e < 8; ++e) o.s[e] = f2bf(bf2f(x.s[e]) * rs * gn[c0 + e]);
    *(u32x4*)ptr = o.u;
  }
#endif
}

__device__ __forceinline__ void ret_out_item(const Params& p, int layer, int item, char* smem) {
  const int b = item >> 8, c = (item >> 2) & 63, h = item & 3;
  const int tid = TIDX(), lane = tid & 63, wave = tid >> 6, lr = lane & 15, quad = lane >> 4;
  u16* Sc = (u16*)smem;
  u16* Kr = Sc;
  u16* Vt = Sc + 128 * TSTR;
  const u16* proj = PROJ(p);
  const float lg = ret_loggamma(h);
  bf16x8 qf[2][2];
#pragma unroll
  for (int mi = 0; mi < 2; ++mi)
#pragma unroll
    for (int ks = 0; ks < 2; ++ks) {
      float o[8];
      ret_rope8(p, proj, C_RQ + h * 64, b, c * 128 + wave * 32 + mi * 16 + lr, ks * 32 + quad * 8, 1.f, o);
      U8 u;
#pragma unroll
      for (int e = 0; e < 4; ++e) u.w[e] = pack2(o[2 * e], o[2 * e + 1]);
      qf[mi][ks] = u.v;
    }
  __syncthreads();
#pragma unroll 2
  for (int i = 0; i < 4; ++i) {
    int cc = tid + i * 256, l = cc >> 3, d0 = (cc & 7) * 8;
    float o[8];
    ret_rope8(p, proj, C_RK + h * 64, b, c * 128 + l, d0, 0.125f, o);
    U8 u;
#pragma unroll
    for (int e = 0; e < 4; ++e) u.w[e] = pack2(o[2 * e], o[2 * e + 1]);
    *(u32x4*)(Kr + l * 72 + d0) = u.u;
  }
#pragma unroll 2
  for (int i = 0; i < 4; ++i) {
    int cc = tid + i * 256, l = cc >> 3, v0 = (cc & 7) * 8;
    U8 x; x.u = *(const u32x4*)(proj + (long)(b * S_ + c * 128 + l) * DINP_ + C_RV + h * 64 + v0);
#pragma unroll
    for (int e = 0; e < 8; ++e) Vt[(v0 + e) * TSTR + l] = x.s[e];
  }
  __syncthreads();
  f32x4 gacc[2][8];
#pragma unroll
  for (int ni = 0; ni < 8; ++ni) { gacc[0][ni] = (f32x4){0.f, 0.f, 0.f, 0.f}; gacc[1][ni] = (f32x4){0.f, 0.f, 0.f, 0.f}; }
#pragma unroll
  for (int ni = 0; ni < 8; ++ni) {
    if (ni < 2 * (wave + 1)) {
#pragma unroll
      for (int ks = 0; ks < 2; ++ks) {
        bf16x8 bb = *(const bf16x8*)(Kr + (ni * 16 + lr) * 72 + ks * 32 + quad * 8);
        gacc[0][ni] = MFMA(qf[0][ks], bb, gacc[0][ni]);
        gacc[1][ni] = MFMA(qf[1][ks], bb, gacc[1][ni]);
      }
    }
  }
  __syncthreads();
#pragma unroll
  for (int ni = 0; ni < 8; ++ni) {
    if (ni < 2 * (wave + 1)) {
      const int s = ni * 16 + lr;
#pragma unroll
      for (int mi = 0; mi < 2; ++mi)
#pragma unroll
        for (int j = 0; j < 4; ++j) {
          const int l = wave * 32 + mi * 16 + quad * 4 + j;
          float v = (s <= l) ? gacc[mi][ni][j] * __expf((float)(l - s) * lg) : 0.f;
          Sc[l * TSTR + s] = f2bf(v);
        }
    }
  }
  __syncthreads();
  f32x4 y[2][4];
#pragma unroll
  for (int mi = 0; mi < 2; ++mi)
#pragma unroll
    for (int ni = 0; ni < 4; ++ni) y[mi][ni] = (f32x4){0.f, 0.f, 0.f, 0.f};
  const float* prev = (const float*)(WSP(p) + OFF_R + R_RETST) + (long)((b * 64 + c) * 4 + h) * 4096;
#pragma unroll
  for (int ks = 0; ks < 2; ++ks)
#pragma unroll
    for (int ni = 0; ni < 4; ++ni) {
      const float4* pp = (const float4*)(prev + (ni * 16 + lr) * 64 + ks * 32 + quad * 8);
      float4 f0 = pp[0], f1 = pp[1];
      U8 u;
      u.w[0] = pack2(f0.x, f0.y); u.w[1] = pack2(f0.z, f0.w); u.w[2] = pack2(f1.x, f1.y); u.w[3] = pack2(f1.z, f1.w);
      y[0][ni] = MFMA(qf[0][ks], u.v, y[0][ni]);
      y[1][ni] = MFMA(qf[1][ks], u.v, y[1][ni]);
    }
#pragma unroll
  for (int mi = 0; mi < 2; ++mi)
#pragma unroll
    for (int j = 0; j < 4; ++j) {
      const float e = __expf((float)(wave * 32 + mi * 16 + quad * 4 + j + 1) * lg);
#pragma unroll
      for (int ni = 0; ni < 4; ++ni) y[mi][ni][j] *= e;
    }
#pragma unroll
  for (int ks = 0; ks < 4; ++ks) {
    if (ks < wave + 1) {
      bf16x8 a0 = *(const bf16x8*)(Sc + (wave * 32 + lr) * TSTR + ks * 32 + quad * 8);
      bf16x8 a1 = *(const bf16x8*)(Sc + (wave * 32 + 16 + lr) * TSTR + ks * 32 + quad * 8);
#pragma unroll
      for (int ni = 0; ni < 4; ++ni) {
        bf16x8 bb = *(const bf16x8*)(Vt + (ni * 16 + lr) * TSTR + ks * 32 + quad * 8);
        y[0][ni] = MFMA(a0, bb, y[0][ni]);
        y[1][ni] = MFMA(a1, bb, y[1][ni]);
      }
    }
  }
  u16* mix = (u16*)(WSP(p) + OFF_HBF);
#pragma unroll
  for (int mi = 0; mi < 2; ++mi)
#pragma unroll
    for (int j = 0; j < 4; ++j) {
      const int l = wave * 32 + mi * 16 + quad * 4 + j;
      const long tok = (long)b * S_ + c * 128 + l;
      float sq = 0.f;
#pragma unroll
      for (int ni = 0; ni < 4; ++ni) sq += y[mi][ni][j] * y[mi][ni][j];
      sq += __shfl_xor(sq, 1); sq += __shfl_xor(sq, 2); sq += __shfl_xor(sq, 4); sq += __shfl_xor(sq, 8);
      const float rs = rsqrtf(sq * (1.f / 64.f) + EPS_);
#pragma unroll
      for (int ni = 0; ni < 4; ++ni) {
        const int v = ni * 16 + lr;
        const float gt = silu_f(bf2f(proj[tok * DINP_ + C_RG + h * 64 + v]));
        mix[tok * 1024 + 512 + h * 64 + v] = f2bf(y[mi][ni][j] * rs * gt);
      }
    }
}

__device__ __forceinline__ void nsa_item(const Params& p, int item, char* smem) {
  const int b = item >> 8, t0 = (item & 255) * 32;
  const int tid = TIDX(), lane = tid & 63, wave = tid >> 6, lr = lane & 15, quad = lane >> 4;
  u16* Ks = (u16*)smem;
  u16* Vs = Ks + 64 * 72;
  float* imp = (float*)(smem + 18432);
  u64* selm = (u64*)(smem + 18432 + 16384);
  const u16* proj = PROJ(p);
  const int hq = lr & 3;
  const float slope = exp2f(-2.f * (float)(hq + 1)) * 1.4426950408889634f;
  const float c8 = 0.125f * 1.4426950408889634f;
  int tq[2];
  bf16x8 qf[2][2];
  float gt[2][3];
#pragma unroll
  for (int qt = 0; qt < 2; ++qt) {
    tq[qt] = t0 + wave * 8 + qt * 4 + (lr >> 2);
    const u16* row = proj + (long)(b * S_ + tq[qt]) * DINP_;
#pragma unroll
    for (int ks = 0; ks < 2; ++ks) {
      U8 x; x.u = *(const u32x4*)(row + C_NQ + hq * 64 + ks * 32 + quad * 8);
#pragma unroll
      for (int e = 0; e < 4; ++e) x.w[e] = pack2(bf2f(x.s[2 * e]) * c8, bf2f(x.s[2 * e + 1]) * c8);
      qf[ks][qt] = x.v;
    }
#pragma unroll
    for (int j = 0; j < 3; ++j) gt[qt][j] = sigm_f(bf2f(row[C_GATE + hq * 3 + j]));
  }
  f32x4* finl = (f32x4*)(smem + 18432 + 16384 + 512);
  __syncthreads();
  for (int i = tid; i < 4096; i += 256) imp[i] = 0.f;

  auto kf = [=](int kt, int ks) { return *(const bf16x8*)(Ks + (kt * 16 + lr) * 72 + ks * 32 + quad * 8); };
  auto vf = [=](int dt, int kk) {
    U8 u;
    u.d[0] = *(const u64*)(Vs + (dt * 16 + lr) * 72 + kk * 32 + quad * 4);
    u.d[1] = *(const u64*)(Vs + (dt * 16 + lr) * 72 + kk * 32 + 16 + quad * 4);
    return u.v;
  };
  auto kdst = [=](int c) { return (c >> 3) * 72 + (c & 7) * 8; };
  f32x4 o[4][2];
  float m[2], l[2];
  auto reset = [&]() {
#pragma unroll
    for (int dt = 0; dt < 4; ++dt) { o[dt][0] = (f32x4){0.f, 0.f, 0.f, 0.f}; o[dt][1] = (f32x4){0.f, 0.f, 0.f, 0.f}; }
    m[0] = m[1] = -1e30f; l[0] = l[1] = 0.f;
  };
  auto accum = [&](int gi) {
#pragma unroll
    for (int qt = 0; qt < 2; ++qt) {
      float lt = l[qt];
      lt += __shfl_xor(lt, 16);
      lt += __shfl_xor(lt, 32);
      const float sc = lt > 0.f ? gt[qt][gi] / lt : 0.f;
#pragma unroll
      for (int dt = 0; dt < 4; ++dt) {
        f32x4* fp = finl + ((wave * 32 + qt * 16 + lr) * 16 + dt * 4 + quad);
        if (gi == 0) *fp = o[dt][qt] * sc; else *fp = *fp + o[dt][qt] * sc;
      }
    }
  };

  const u16* kc = (const u16*)(WSP(p) + OFF_R + R_KCMP) + (long)b * 512 * 64;
  const u16* vct = (const u16*)(WSP(p) + OFF_R + R_VCT) + (long)b * 64 * 512;
  const int nvmax = t0 / 16 + 1;
  const int ntc = (nvmax + 63) >> 6;
  auto kcs = [=](int t, int c) { return kc + (long)(t * 64 + (c >> 3)) * 64 + (c & 7) * 8; };
  auto vcs = [=](int t, int c) { return vct + (long)(c >> 3) * 512 + t * 64 + (c & 7) * 8; };
  reset();
  const float slope16 = 16.f * slope;
  const int tw0 = t0 + wave * 8;
  const int jlw = tw0 >= 31 ? ((tw0 - 31) >> 4) : -1;
  flash_loop<2>(0, ntc, kcs, kdst, vcs, Ks, Vs, [&](int t) {
    const int jb = t * 64 + quad * 4;
    const int cl0 = (tq[0] >= 31 ? ((tq[0] - 31) >> 4) : -1) - jb, cl1 = (tq[1] >= 31 ? ((tq[1] - 31) >> 4) : -1) - jb;
    const float cf0 = -slope * ((float)(tq[0] - 16 * jb) - 15.5f), cf1 = -slope * ((float)(tq[1] - 16 * jb) - 15.5f);
    const float of0 = cf0 + ft_shift(m[0]), of1 = cf1 + ft_shift(m[1]);
    if (t * 64 + 63 > jlw) flash_tile2<2, false>(kf, vf, AlibiInit<true>{slope16, of0, of1, cl0, cl1, 1 << 20}, NoHook(), qf, o, m, l);
    else flash_tile2<2, false>(kf, vf, AlibiInit<false>{slope16, of0, of1, cl0, cl1, 1 << 20}, NoHook(), qf, o, m, l);
  });
  float invl[2];
#pragma unroll
  for (int qt = 0; qt < 2; ++qt) {
    float lt = l[qt];
    lt += __shfl_xor(lt, 16);
    lt += __shfl_xor(lt, 32);
    invl[qt] = lt > 0.f ? 1.f / lt : 0.f;
    l[qt] = 0.f;
  }
  flash_loop<2>(0, ntc, kcs, kdst, vcs, Ks, Vs, [&](int t) {
    const int jb = t * 64 + quad * 4;
    const int cl0 = (tq[0] >= 31 ? ((tq[0] - 31) >> 4) : -1) - jb, cl1 = (tq[1] >= 31 ? ((tq[1] - 31) >> 4) : -1) - jb;
    const float cf0 = -slope * ((float)(tq[0] - 16 * jb) - 15.5f), cf1 = -slope * ((float)(tq[1] - 16 * jb) - 15.5f);
    const float of0 = cf0 + ft_shift(m[0]), of1 = cf1 + ft_shift(m[1]);
    auto hook = [=](int qt, float (&pv)[4][4]) {
#pragma unroll
      for (int kt = 0; kt < 4; ++kt) {
        float v3 = pv[kt][3] * invl[qt];
        float vs = (pv[kt][0] + pv[kt][1] + pv[kt][2]) * invl[qt] + v3;
        vs += dpp_xor1(vs); vs += dpp_xor2(vs);
        v3 += dpp_xor1(v3); v3 += dpp_xor2(v3);
        if (hq == 0) {
          const int blk = t * 16 + kt * 4 + quad;
          float* ip = imp + (wave * 8 + qt * 4 + (lr >> 2)) * 128;
          atomicAdd(ip + blk, vs);
          if (blk + 1 < 128) atomicAdd(ip + blk + 1, v3);
        }
      }
    };
    if (t * 64 + 63 > jlw) flash_tile2<2, true>(kf, vf, AlibiInit<true>{slope16, of0, of1, cl0, cl1, 1 << 20}, hook, qf, o, m, l);
    else flash_tile2<2, true>(kf, vf, AlibiInit<false>{slope16, of0, of1, cl0, cl1, 1 << 20}, hook, qf, o, m, l);
  });
  accum(0);
  __syncthreads();

  unsigned* usel = (unsigned*)(smem + 18432 + 16384 + 512 + 32768);
  if (tid < 4) usel[tid] = 0u;
  unsigned ulo0 = 0, ulo1 = 0, uhi0 = 0, uhi1 = 0;
#pragma unroll 1
  for (int qi = 0; qi < 8; ++qi) {
    const int t = t0 + wave * 8 + qi, qblk = t >> 6;
    float* ip = imp + (wave * 8 + qi) * 128;
    unsigned k0, k1;
    {
      const int b0 = lane, b1 = lane + 64;
      const unsigned u0 = __float_as_uint(ip[lane]) & 0xFFFFFF80u, u1 = __float_as_uint(ip[64 + lane]) & 0xFFFFFF80u;
      k0 = (b0 > qblk) ? 0u : ((b0 == 0 || b0 == qblk || b0 == qblk - 1) ? 0xFFFFFF80u : u0);
      k1 = (b1 > qblk) ? 0u : ((b1 == qblk || b1 == qblk - 1) ? 0xFFFFFF80u : u1);
      k0 |= (unsigned)(127 - b0);
      k1 |= (unsigned)(127 - b1);
    }
    unsigned* kp = (unsigned*)ip;
    kp[lane] = k0; kp[64 + lane] = k1;
    asm volatile("s_waitcnt lgkmcnt(0)" ::: "memory");
    int r0 = 0, r1 = 0;
#pragma unroll 8
    for (int j4 = 0; j4 < 32; ++j4) {
      const u32x4 w = *(const u32x4*)(kp + j4 * 4);
#pragma unroll
      for (int e = 0; e < 4; ++e) {
        r0 += (w[e] > k0) ? 1 : 0;
        r1 += (w[e] > k1) ? 1 : 0;
      }
    }
    u64 mlo = __ballot(r0 < 16 && lane <= qblk);
    u64 mhi = __ballot(r1 < 16 && lane + 64 <= qblk);
    if (lane == 0) { selm[(wave * 8 + qi) * 2] = mlo; selm[(wave * 8 + qi) * 2 + 1] = mhi; }
    ulo0 |= (unsigned)mlo; ulo1 |= (unsigned)(mlo >> 32); uhi0 |= (unsigned)mhi; uhi1 |= (unsigned)(mhi >> 32);
  }
  __syncthreads();
  if (lane == 0) { atomicOr(usel + 0, ulo0); atomicOr(usel + 1, ulo1); atomicOr(usel + 2, uhi0); atomicOr(usel + 3, uhi1); }
  __syncthreads();
  u64 sm_lo[2], sm_hi[2];
#pragma unroll
  for (int qt = 0; qt < 2; ++qt) {
    sm_lo[qt] = selm[(wave * 8 + qt * 4 + (lr >> 2)) * 2];
    sm_hi[qt] = selm[(wave * 8 + qt * 4 + (lr >> 2)) * 2 + 1];
  }
  reset();
  {
    const u16* ksb = proj + (long)b * S_ * DINP_ + C_NKS;
    const u16* vst = (const u16*)(WSP(p) + OFF_VST) + (long)b * 64 * 8192;
    LAS int* blist = (LAS int*)imp;
    int nun = 0;
    {
      const unsigned u0 = usel[0], u1 = usel[1], u2 = usel[2], u3 = usel[3];
      __syncthreads();
      if (tid < 128) {
        const unsigned wd = tid < 32 ? u0 : tid < 64 ? u1 : tid < 96 ? u2 : u3;
        const int bit = tid & 31;
        if ((wd >> bit) & 1u) {
          int pos = __popc(wd & ((1u << bit) - 1u));
          if (tid >= 32) pos += __popc(u0);
          if (tid >= 64) pos += __popc(u1);
          if (tid >= 96) pos += __popc(u2);
          blist[pos] = tid;
        }
      }
      nun = __popc(u0) + __popc(u1) + __popc(u2) + __popc(u3);
      __syncthreads();
    }
    const unsigned w0m = __builtin_amdgcn_readfirstlane(ulo0), w1m = __builtin_amdgcn_readfirstlane(ulo1),
                   w2m = __builtin_amdgcn_readfirstlane(uhi0), w3m = __builtin_amdgcn_readfirstlane(uhi1);
    flash_loop<2>(0, nun,
        [=](int blk, int c) { return ksb + (long)(blk * 64 + (c >> 3)) * DINP_ + (c & 7) * 8; }, kdst,
        [=](int blk, int c) { return vst + (long)(c >> 3) * 8192 + blk * 64 + (c & 7) * 8; }, Ks, Vs,
        [&](int blk) {
          const unsigned wm = blk < 32 ? w0m : blk < 64 ? w1m : blk < 96 ? w2m : w3m;
          if ((wm >> (blk & 31)) & 1u) {
            const int k0 = blk * 64;
            const bool s0 = ((blk < 64 ? sm_lo[0] : sm_hi[0]) >> (blk & 63)) & 1ull;
            const bool s1 = ((blk < 64 ? sm_lo[1] : sm_hi[1]) >> (blk & 63)) & 1ull;
            const int l0 = tq[0] - k0 - quad * 4, l1 = tq[1] - k0 - quad * 4;
            const float f0 = s0 ? -slope * (float)l0 + ft_shift(m[0]) : -INFINITY, f1 = s1 ? -slope * (float)l1 + ft_shift(m[1]) : -INFINITY;
            if (k0 + 63 > tw0) flash_tile2<2, true>(kf, vf, AlibiInit<true>{slope, f0, f1, l0, l1, 1 << 20}, NoHook(), qf, o, m, l);
            else flash_tile2<2, true>(kf, vf, AlibiInit<false>{slope, f0, f1, l0, l1, 1 << 20}, NoHook(), qf, o, m, l);
          }
        }, [=](int t) { return (int)blist[t]; });
  }
  accum(1);
  reset();
  {
    const u16* kwb = proj + (long)b * S_ * DINP_ + C_NKW;
    const u16* vwt = (const u16*)(WSP(p) + OFF_VWT) + (long)b * 64 * 8192;
    const int w0 = (t0 >= 511 ? t0 - 511 : 0) >> 6, w1 = ((t0 + 31) >> 6) + 1;
    flash_loop<2>(w0, w1,
        [=](int t, int c) { return kwb + (long)(t * 64 + (c >> 3)) * DINP_ + (c & 7) * 8; }, kdst,
        [=](int t, int c) { return vwt + (long)(c >> 3) * 8192 + t * 64 + (c & 7) * 8; }, Ks, Vs,
        [&](int t) {
          const int l0 = tq[0] - t * 64 - quad * 4, l1 = tq[1] - t * 64 - quad * 4;
          const float f0 = -slope * (float)l0 + ft_shift(m[0]), f1 = -slope * (float)l1 + ft_shift(m[1]);
          if (t * 64 + 63 > tw0 || t * 64 <= tw0 + 7 - 512) flash_tile2<2, true>(kf, vf, AlibiInit<true>{slope, f0, f1, l0, l1, 512}, NoHook(), qf, o, m, l);
          else flash_tile2<2, true>(kf, vf, AlibiInit<false>{slope, f0, f1, l0, l1, 512}, NoHook(), qf, o, m, l);
        });
  }
  accum(2);
  u16* mix = (u16*)(WSP(p) + OFF_HBF);
#pragma unroll
  for (int qt = 0; qt < 2; ++qt) {
    u16* orow = mix + (long)(b * S_ + tq[qt]) * 1024 + 768 + hq * 64;
#pragma unroll
    for (int dt = 0; dt < 4; ++dt) {
      const f32x4 fv = finl[(wave * 32 + qt * 16 + lr) * 16 + dt * 4 + quad];
      u32x2 pk;
      pk.x = pack2(fv[0], fv[1]);
      pk.y = pack2(fv[2], fv[3]);
      *(u32x2*)(orow + dt * 16 + quad * 4) = pk;
    }
  }
}

__device__ __forceinline__ void phase4(const Params& p, int layer, char* smem) {
  int* cnt = (int*)(WSP(p) + OFF_CNT) + layer * 16;
  QLOOP(13, 384, mla_combine_item(p, it))
  QLOOP(10, 512, ssd_out_item(p, layer, it, smem))
  QLOOP_X(40, 64, nsa_item(p, qx * 64 + 63 - qd, smem))
  QLOOP(12, 512, ret_out_item(p, layer, it, smem))
}


#define XB_TMO      128
#define XB_XCNT(j)  (256  + 64 * (j))
#define XB_XSUB(j)  (1280 + 64 * (j))
#define XB_XGEN(j)  (2304 + 64 * (j))
#define XB_TOP      3328
#define XB_TOPGEN   3392
#define XCD_BAR_WORDS 3456
#define XB_SPIN_CAP (1u << 20)
__device__ __forceinline__ unsigned xb_ld(unsigned* p) { return __hip_atomic_load(p, __ATOMIC_RELAXED, __HIP_MEMORY_SCOPE_AGENT); }
__device__ __forceinline__ unsigned xb_add(unsigned* p, unsigned v) { return __hip_atomic_fetch_add(p, v, __ATOMIC_RELAXED, __HIP_MEMORY_SCOPE_AGENT); }
__device__ __forceinline__ unsigned xb_xcc_id() { return (unsigned)__builtin_amdgcn_s_getreg((3 << 11) | 20) & 0xFu; }
#define XB_SPIN(cond, bar) do { unsigned _sp = 0; while (cond) { __builtin_amdgcn_s_sleep(1); \
    if ((++_sp & 255u) == 0u) { if (xb_ld(&(bar)[XB_TMO])) break; if (_sp > XB_SPIN_CAP) { atomicAdd(&(bar)[XB_TMO], 1u); break; } } } } while (0)
struct XcdBarrier { unsigned* bar; unsigned x; volatile LAS unsigned* st; };
__device__ __forceinline__ XcdBarrier xcd_barrier_post(unsigned* bar, volatile LAS unsigned* st) {
  XcdBarrier b; b.bar = bar; b.x = xb_xcc_id(); b.st = st;
  if (__builtin_amdgcn_workitem_id_x() == 0) (void)xb_add(&bar[XB_XCNT(b.x)], 1u);
  return b;
}
__device__ __forceinline__ void xcd_barrier_complete(unsigned* bar, unsigned x, unsigned& nloc, unsigned& nx) {
  const unsigned G = gridDim.x * gridDim.y * gridDim.z;
  unsigned sum, cnt, mine, sp = 0u;
  for (;;) {
    sum = 0u; cnt = 0u; mine = 0u;
#pragma unroll
    for (unsigned j = 0; j < 16; ++j) { const unsigned c = xb_ld(&bar[XB_XCNT(j)]); sum += c; cnt += (c > 0u) ? 1u : 0u; mine = (j == x) ? c : mine; }
    if (sum == G) break;
    __builtin_amdgcn_s_sleep(1);
    if ((++sp & 255u) == 0u) { if (xb_ld(&bar[XB_TMO])) break; if (sp > XB_SPIN_CAP) { atomicAdd(&bar[XB_TMO], 1u); break; } }
  }
  nloc = mine > 0u ? mine : 1u; nx = cnt > 0u ? cnt : 1u;
}
__device__ __forceinline__ void xcd_barrier(const XcdBarrier& b) {
  asm volatile("s_waitcnt vmcnt(0)" ::: "memory");
  __syncthreads();
  if (__builtin_amdgcn_workitem_id_x() == 0) {
    unsigned* bar = b.bar;
    __builtin_amdgcn_s_waitcnt(0);
    unsigned nloc = b.st[0], nx = b.st[1];
    if (nloc == 0u) { xcd_barrier_complete(bar, b.x, nloc, nx); b.st[0] = nloc; b.st[1] = nx; }
    const unsigned old = xb_add(&bar[XB_XSUB(b.x)], 1u);
    const unsigned gen = old / nloc;
    if (old + 1u == (gen + 1u) * nloc) {
      __builtin_amdgcn_fence(__ATOMIC_RELEASE, "agent");
      asm volatile("s_waitcnt vmcnt(0)" ::: "memory");
      const unsigned og = xb_add(&bar[XB_TOP], 1u);
      const unsigned tg = og / nx;
      if (og + 1u == (tg + 1u) * nx) xb_add(&bar[XB_TOPGEN], 1u);
      else XB_SPIN(xb_ld(&bar[XB_TOPGEN]) == tg, bar);
      __builtin_amdgcn_fence(__ATOMIC_ACQUIRE, "agent");
      xb_add(&bar[XB_XGEN(b.x)], 1u);
      asm volatile("s_waitcnt vmcnt(0)" ::: "memory");
    } else {
      XB_SPIN(xb_ld(&bar[XB_XGEN(b.x)]) == gen, bar);
      __builtin_amdgcn_fence(__ATOMIC_ACQUIRE, "agent");
      asm volatile("s_waitcnt vmcnt(0)" ::: "memory");
    }
  }
  __syncthreads();
}

constexpr int NPHASE = 1 + 9 * 2;
template <int KIND>
__device__ __forceinline__ void run_kind(const Params& p, int layer, int bid, int nb, char* smem) {
  if (KIND == 9) phase0(p, bid, nb, smem);
  if (KIND == 0) phase_inproj(p, bid, nb, smem);
  if (KIND == 1) phase2(p, layer, smem);
  if (KIND == 2) phase3(p, layer, smem);
  if (KIND == 3) phase4(p, layer, smem);
  if (KIND == 4) phase_resgemm<true>(p, bid, nb, smem, (const u16*)(WSP(p) + OFF_HBF), 1024, (const u16*)(WSP(p) + OFF_WT_OUT),
                                     layer == 0 ? nullptr : (const float*)(WSP(p) + OFF_LNST) + (long)T_ * 2, INP(p, I_LN2G), INP(p, I_LN2B));
  if (KIND == 5) phase_ln(p, bid, nb, smem, INP(p, I_LN1G) + layer * 1024, INP(p, I_LN1B) + layer * 1024, -1, 0, false);
  if (KIND == 6) phase_mlp1(p, bid, nb, smem);
  if (KIND == 7) phase_resgemm<false>(p, bid, nb, smem, (const u16*)(WSP(p) + OFF_R), 4096, (const u16*)(WSP(p) + OFF_WT_M2),
                                      (const float*)(WSP(p) + OFF_LNST), INP(p, I_LN1G) + layer * 1024, INP(p, I_LN1B) + layer * 1024);
  if (KIND == 8) phase_ln(p, bid, nb, smem, INP(p, I_LN2G) + layer * 1024, INP(p, I_LN2B) + layer * 1024, layer == 0 ? 1 : -1, 1, layer == 1);
}

#if MEGA
__global__ void __launch_bounds__(256, 2) mega_kernel(Params p) {
  __shared__ __attribute__((aligned(16))) char smem[SMEM_BYTES];
  cg::grid_group grid = cg::this_grid();
  const int bid = blockIdx.x, nb = gridDim.x;
  volatile LAS unsigned* st = (volatile LAS unsigned*)(smem + SMEM_BYTES - 32);
  if (__builtin_amdgcn_workitem_id_x() == 0) { st[0] = 0u; st[1] = 0u; }
  __syncthreads();
  if (bid == 0) { unsigned* bw = (unsigned*)(p.ws + OFF_BAR); for (int i = __builtin_amdgcn_workitem_id_x(); i < XCD_BAR_WORDS; i += 256) bw[i] = 0u; }
  run_kind<9>(p, 0, bid, nb, smem);
  grid.sync();
  XcdBarrier xb = xcd_barrier_post((unsigned*)(p.ws + OFF_BAR), st);
#pragma unroll 1
  for (int layer = 0; layer < 2; ++layer) {
    run_kind<0>(p, layer, bid, nb, smem); xcd_barrier(xb);
    run_kind<1>(p, layer, bid, nb, smem); xcd_barrier(xb);
    run_kind<2>(p, layer, bid, nb, smem); xcd_barrier(xb);
    run_kind<3>(p, layer, bid, nb, smem); xcd_barrier(xb);
    run_kind<4>(p, layer, bid, nb, smem); xcd_barrier(xb);
    run_kind<5>(p, layer, bid, nb, smem); xcd_barrier(xb);
    run_kind<6>(p, layer, bid, nb, smem); xcd_barrier(xb);
    run_kind<7>(p, layer, bid, nb, smem); xcd_barrier(xb);
    run_kind<8>(p, layer, bid, nb, smem);
    if (layer == 0) xcd_barrier(xb);
  }
}
#else
template <int KIND>
__global__ void __launch_bounds__(256, 2) phase_kernel(Params p, int layer) {
  __shared__ __attribute__((aligned(16))) char smem[SMEM_BYTES];
  run_kind<KIND>(p, layer, blockIdx.x, gridDim.x, smem);
}
#endif

extern "C" void kernel_launch(void* const* d_in, const int* in_sizes, int n_in, void* d_out, int out_size, void* d_ws,
                              size_t ws_size, hipStream_t stream) {
  if (n_in != 27 || ws_size < WS_TOTAL) { fprintf(stderr, "kernel_launch: bad inputs n_in=%d ws=%zu need %zu\n", n_in, ws_size, (size_t)WS_TOTAL); return; }
  Params p{};
  for (int i = 0; i < 27; ++i) p.in[i] = (const float*)d_in[i];
  p.h32 = (float*)d_out;
  p.ws = (char*)d_ws;
#if MEGA
  static int grid_blocks = 0;
  if (!grid_blocks) {
    int dev = 0, cus = 0, per_cu = 0;
    hipGetDevice(&dev);
    hipDeviceGetAttribute(&cus, hipDeviceAttributeMultiprocessorCount, dev);
    hipOccupancyMaxActiveBlocksPerMultiprocessor(&per_cu, mega_kernel, 256, 0);
    if (per_cu > 2) per_cu = 2;
    grid_blocks = cus * per_cu;
    fprintf(stderr, "kernel_launch: cus=%d per_cu=%d grid=%d\n", cus, per_cu, grid_blocks);
  }
  void* args[] = {&p};
  hipError_t e = hipLaunchCooperativeKernel((void*)mega_kernel, dim3(grid_blocks), dim3(256), args, 0, stream);
  if (e != hipSuccess) fprintf(stderr, "cooperative launch failed: %s (grid %d)\n", hipGetErrorString(e), grid_blocks);
#else
  hipLaunchKernelGGL(phase_kernel<9>, dim3(512), dim3(256), 0, stream, p, 0);
  for (int layer = 0; layer < 2; ++layer) {
    hipLaunchKernelGGL(phase_kernel<0>, dim3(512), dim3(256), 0, stream, p, layer);
    hipLaunchKernelGGL(phase_kernel<1>, dim3(512), dim3(256), 0, stream, p, layer);
    hipLaunchKernelGGL(phase_kernel<2>, dim3(512), dim3(256), 0, stream, p, layer);
    hipLaunchKernelGGL(phase_kernel<3>, dim3(512), dim3(256), 0, stream, p, layer);
    hipLaunchKernelGGL(phase_kernel<4>, dim3(512), dim3(256), 0, stream, p, layer);
    hipLaunchKernelGGL(phase_kernel<5>, dim3(512), dim3(256), 0, stream, p, layer);
    hipLaunchKernelGGL(phase_kernel<6>, dim3(512), dim3(256), 0, stream, p, layer);
    hipLaunchKernelGGL(phase_kernel<7>, dim3(512), dim3(256), 0, stream, p, layer);
    hipLaunchKernelGGL(phase_kernel<8>, dim3(512), dim3(256), 0, stream, p, layer);
  }
#endif
}
```

```cpp
#include <hip/hip_runtime.h>
#include <hip/hip_cooperative_groups.h>
#include <cstdio>
namespace cg = cooperative_groups;

#ifndef MEGA
#define MEGA 1
#endif

typedef unsigned short u16;
typedef unsigned long long u64;
typedef __attribute__((ext_vector_type(8))) short bf16x8;
typedef __attribute__((ext_vector_type(4))) float f32x4;
typedef unsigned __attribute__((ext_vector_type(4))) u32x4;
typedef unsigned __attribute__((ext_vector_type(2))) u32x2;
#define LAS __attribute__((address_space(3)))
#define GAS __attribute__((address_space(1)))
#define MFMA(a, b, c) __builtin_amdgcn_mfma_f32_16x16x32_bf16(a, b, c, 0, 0, 0)

constexpr int S_ = 8192, T_ = 16384, DM_ = 1024, DINP_ = 3200, DFF_ = 4096;
constexpr int C_Z = 0, C_XS = 256, C_CQ = 1024, C_CKV = 1280, C_KR = 1408, C_RQ = 1440, C_RK = 1696, C_RV = 1952,
              C_RG = 2208, C_NQ = 2464, C_NKC = 2720, C_NVC = 2784, C_NKS = 2848, C_NVS = 2912, C_NKW = 2976,
              C_NVW = 3040, C_DT = 3104, C_GATE = 3108;
constexpr float EPS_ = 1e-5f;
constexpr float ALPHA_ = 1.41421356237309515f;

constexpr size_t OFF_WT_IN = 0, OFF_WT_OUT = 6553600, OFF_WT_M1 = 8650752, OFF_WT_M2 = 17039360, OFF_WT_UQ = 25427968,
                 OFF_WT_UKV = 25624576, OFF_WT_C1K = 25755648, OFF_WT_C1V = 26804224, OFF_WT_C2K = 27852800,
                 OFF_WT_C2V = 27918336, OFF_BIASP = 27983872, OFF_COSM = 28016640, OFF_SINM = 28540928,
                 OFF_COSR = 29065216, OFF_SINR = 30113792, OFF_CNT = 31162368, OFF_SSDDEC = 31166464,
                 OFF_R = 31170560, OFF_HBF = 165388288, OFF_QMLA = 198942720, OFF_KBUF = 211525632,
                 OFF_VTMLA = 224108544, OFF_VST = 232497152, OFF_VWT = 234594304, OFF_BAR = 236691456, OFF_SSQ = 236691456 + 16384, OFF_MLAP = 236969984, OFF_MLAML = 257941504, OFF_LNST = 259252224, WS_TOTAL = 259252224 + 262144;
constexpr size_t R_PROJ = 0, R_SSDST = 105267200, R_RETST = 122044416, R_HID = 130433024, R_KCMP = 131481600,
                 R_VCT = 131612672;

constexpr int SMEM_BYTES = 75776;
constexpr int GSTR = 72;
constexpr int TSTR = 136;

struct Params {
  const float* in[27];
  float* h32;
  char* ws;
};
enum { I_X = 0, I_LNEG, I_LNEB, I_WIN, I_CONVW, I_CONVB, I_DTB, I_ALOG, I_DSKIP, I_SSMG, I_QNG, I_WUQ, I_KVNG, I_WUKV,
       I_PEK, I_W1K, I_W2K, I_PEV, I_W1V, I_W2V, I_WOUT, I_LN1G, I_LN1B, I_WM1, I_WM2, I_LN2G, I_LN2B };


__device__ __forceinline__ int TIDX() { int t = __builtin_amdgcn_workitem_id_x(); asm volatile("" : "+v"(t)); return t; }

__device__ __forceinline__ char* WSP(const Params& p) { GAS char* w = (GAS char*)p.ws; asm volatile("" : "+s"(w)); return (char*)w; }
__device__ __forceinline__ const float* INP(const Params& p, int i) { GAS const float* q = (GAS const float*)p.in[i]; asm volatile("" : "+s"(q)); return (const float*)q; }
union U8 { u32x4 u; bf16x8 v; u16 s[8]; unsigned w[4]; u64 d[2]; };

__device__ __forceinline__ float bf2f(u16 v) { return __uint_as_float(((unsigned)v) << 16); }
typedef __bf16 bf16v2_t __attribute__((ext_vector_type(2)));
typedef float floatv2_t __attribute__((ext_vector_type(2)));
__device__ __forceinline__ u16 f2bf(float f) { return __builtin_bit_cast(u16, (__bf16)f); }
__device__ __forceinline__ unsigned pack2(float a, float b) { floatv2_t f = {a, b}; return __builtin_bit_cast(unsigned, __builtin_convertvector(f, bf16v2_t)); }
__device__ __forceinline__ float silu_f(float x) { return x * __builtin_amdgcn_rcpf(1.f + __expf(-x)); }
__device__ __forceinline__ float sigm_f(float x) { return __builtin_amdgcn_rcpf(1.f + __expf(-x)); }
__device__ __forceinline__ float dpp_xor1(float v) { return __int_as_float(__builtin_amdgcn_mov_dpp(__float_as_int(v), 0xB1, 0xF, 0xF, true)); }
__device__ __forceinline__ float dpp_xor2(float v) { return __int_as_float(__builtin_amdgcn_mov_dpp(__float_as_int(v), 0x4E, 0xF, 0xF, true)); }
__device__ __forceinline__ float wave_sum(float v) {
#pragma unroll
  for (int o = 32; o > 0; o >>= 1) v += __shfl_xor(v, o);
  return v;
}
__device__ __forceinline__ const u16* PROJ(const Params& p) { return (const u16*)(WSP(p) + OFF_R + R_PROJ); }

__device__ __forceinline__ int next_item(int* counter, char* smem) {
  int* sh = (int*)(smem + SMEM_BYTES - 16);
  __syncthreads();
  if (TIDX() == 0) *sh = atomicAdd(counter, 1);
  __syncthreads();
  return *sh;
}

struct NoMid { __device__ __forceinline__ void operator()(int, f32x4 (&)[4][4]) const {} };
template <bool SWAP, class ARow, class Epi, class Mid = NoMid>
__device__ __forceinline__ void gemm_tile(ARow arow, const int a_kstride, const u16* __restrict__ Bt, const int ldb,
                                          const int K, const int n0, Epi epi, u16* smem, Mid mid = NoMid()) {
  const int tid = TIDX(), lane = tid & 63, wave = tid >> 6;
  const int wm = wave >> 1, wn = wave & 1, lr = lane & 15, quad = lane >> 4;
  const int srow = tid >> 3, sch = tid & 7;
  const u16* ap[4];
  const u16* bp[4];
#pragma unroll
  for (int i = 0; i < 4; ++i) {
    const int r = srow + i * 32;
    const int gch = sch ^ ((r >> 1) & 7);
    ap[i] = arow(r) + gch * 8;
    bp[i] = Bt + (long)(n0 + r) * ldb + gch * 8;
  }
  f32x4 acc[4][4];
#pragma unroll
  for (int i = 0; i < 4; ++i)
#pragma unroll
    for (int j = 0; j < 4; ++j) acc[i][j] = (f32x4){0.f, 0.f, 0.f, 0.f};
  const int nkt = K >> 6;
#define GEMM_STAGE(KT, BUF)                                                                                   \
  {                                                                                                            \
    u16* ab_ = smem + (BUF) * 16384;                                                                           \
    _Pragma("unroll") for (int i = 0; i < 4; ++i) {                                                            \
      __builtin_amdgcn_global_load_lds((GAS const unsigned*)(ap[i] + (long)(KT) * a_kstride),                  \
                                       (LAS unsigned*)(ab_ + (srow + i * 32) * 64 + sch * 8), 16, 0, 0);       \
      __builtin_amdgcn_global_load_lds((GAS const unsigned*)(bp[i] + (KT) * 64),                               \
                                       (LAS unsigned*)(ab_ + 8192 + (srow + i * 32) * 64 + sch * 8), 16, 0, 0); \
    }                                                                                                          \
  }
  __syncthreads();
  GEMM_STAGE(0, 0)
  int aoff[4], boff[4];
#pragma unroll
  for (int mi = 0; mi < 4; ++mi) { const int r = wm * 64 + mi * 16 + lr; aoff[mi] = r * 64; }
#pragma unroll
  for (int ni = 0; ni < 4; ++ni) { const int r = wn * 64 + ni * 16 + lr; boff[ni] = 8192 + r * 64; }
  const int swz = (lr >> 1) & 7;
#pragma unroll 1
  for (int kt = 0; kt < nkt; ++kt) {
    asm volatile("s_waitcnt vmcnt(0)" ::: "memory");
    __syncthreads();
    if (kt + 1 < nkt) GEMM_STAGE(kt + 1, (kt + 1) & 1)
    const u16* buf = smem + (kt & 1) * 16384;
    {
      bf16x8 a[2][4], b[2][4];
#pragma unroll
      for (int ks = 0; ks < 2; ++ks) {
        const int coff = ((ks * 4 + quad) ^ swz) * 8;
#pragma unroll
        for (int mi = 0; mi < 4; ++mi) a[ks][mi] = *(const bf16x8*)(buf + aoff[mi] + coff);
#pragma unroll
        for (int ni = 0; ni < 4; ++ni) b[ks][ni] = *(const bf16x8*)(buf + boff[ni] + coff);
      }
      __builtin_amdgcn_sched_barrier(0);
#pragma unroll
      for (int ks = 0; ks < 2; ++ks)
#pragma unroll
        for (int mi = 0; mi < 4; ++mi)
#pragma unroll
          for (int ni = 0; ni < 4; ++ni)
            acc[mi][ni] = SWAP ? MFMA(b[ks][ni], a[ks][mi], acc[mi][ni]) : MFMA(a[ks][mi], b[ks][ni], acc[mi][ni]);
    }
    mid(kt, acc);
  }
#undef GEMM_STAGE
#pragma unroll
  for (int mi = 0; mi < 4; ++mi) {
#pragma unroll
    for (int ni = 0; ni < 4; ++ni) {
      if (SWAP) epi(wm * 64 + mi * 16 + lr, wn * 64 + ni * 16 + quad * 4, acc[mi][ni]);
      else epi(wm * 64 + mi * 16 + quad * 4, wn * 64 + ni * 16 + lr, acc[mi][ni]);
    }
    asm volatile("" ::: "memory");
  }
}

template <int NKS, bool PV, class KF, class VF, class MB, class PH>
__device__ __forceinline__ void flash_tile(KF kf, VF vf, MB mb, PH ph, const bf16x8 (&qf)[NKS][2], f32x4 (&o)[4][2],
                                           float (&m)[2], float (&l)[2]) {
  const int quad = (TIDX() & 63) >> 4;
  f32x4 s[2][4];
#pragma unroll
  for (int kt = 0; kt < 4; ++kt) {
    s[0][kt] = (f32x4){0.f, 0.f, 0.f, 0.f};
    s[1][kt] = (f32x4){0.f, 0.f, 0.f, 0.f};
#pragma unroll
    for (int ks = 0; ks < NKS; ++ks) {
      bf16x8 a = kf(kt, ks);
      s[0][kt] = MFMA(a, qf[ks][0], s[0][kt]);
      s[1][kt] = MFMA(a, qf[ks][1], s[1][kt]);
    }
  }
  bf16x8 pb[2][2];
#pragma unroll
  for (int qt = 0; qt < 2; ++qt) {
    float mx = -INFINITY;
#pragma unroll
    for (int kt = 0; kt < 4; ++kt)
#pragma unroll
      for (int j = 0; j < 4; ++j) {
        float v = mb(kt * 16 + j, qt, s[qt][kt][j]);
        s[qt][kt][j] = v;
        mx = fmaxf(mx, v);
      }
    mx = fmaxf(mx, __shfl_xor(mx, 16));
    mx = fmaxf(mx, __shfl_xor(mx, 32));
    const float mnew = fmaxf(m[qt], mx);
    const float alpha = __builtin_amdgcn_exp2f(m[qt] - mnew);
    m[qt] = mnew;
    float ps = 0.f;
    float pv[4][4];
#pragma unroll
    for (int kt = 0; kt < 4; ++kt)
#pragma unroll
      for (int j = 0; j < 4; ++j) {
        float e = __builtin_amdgcn_exp2f(s[qt][kt][j] - mnew);
        pv[kt][j] = e;
        ps += e;
      }
    l[qt] = l[qt] * alpha + ps;
    ph(qt, pv);
    if (PV) {
#pragma unroll
      for (int dt = 0; dt < 4; ++dt) o[dt][qt] *= alpha;
#pragma unroll
      for (int kk = 0; kk < 2; ++kk) {
        U8 u;
        u.w[0] = pack2(pv[2 * kk][0], pv[2 * kk][1]);
        u.w[1] = pack2(pv[2 * kk][2], pv[2 * kk][3]);
        u.w[2] = pack2(pv[2 * kk + 1][0], pv[2 * kk + 1][1]);
        u.w[3] = pack2(pv[2 * kk + 1][2], pv[2 * kk + 1][3]);
        pb[qt][kk] = u.v;
      }
    }
  }
  if (PV) {
#pragma unroll
    for (int kk = 0; kk < 2; ++kk)
#pragma unroll
      for (int dt = 0; dt < 4; ++dt) {
        bf16x8 a = vf(dt, kk);
        o[dt][0] = MFMA(a, pb[0][kk], o[dt][0]);
        o[dt][1] = MFMA(a, pb[1][kk], o[dt][1]);
      }
  }
}

constexpr float FT_T = 16.f;
template <int NKS, bool PV, class KF, class VF, class CI, class PH>
__device__ __forceinline__ void flash_tile2(KF kf, VF vf, CI cin, PH ph, const bf16x8 (&qf)[NKS][2], f32x4 (&o)[4][2],
                                            float (&m)[2], float (&l)[2]) {
  f32x4 s[2][4];
  if (NKS == 2) {
    bf16x8 kfr[4][NKS];
#pragma unroll
    for (int kt = 0; kt < 4; ++kt)
#pragma unroll
      for (int ks = 0; ks < NKS; ++ks) kfr[kt][ks] = kf(kt, ks);
    __builtin_amdgcn_sched_barrier(0);
#pragma unroll
    for (int kt = 0; kt < 4; ++kt) {
      s[0][kt] = cin(0, kt);
      s[1][kt] = cin(1, kt);
#pragma unroll
      for (int ks = 0; ks < NKS; ++ks) {
        s[0][kt] = MFMA(kfr[kt][ks], qf[ks][0], s[0][kt]);
        s[1][kt] = MFMA(kfr[kt][ks], qf[ks][1], s[1][kt]);
      }
    }
  } else {
    bf16x8 kfr[2][NKS];
#pragma unroll
    for (int ks = 0; ks < NKS; ++ks) kfr[0][ks] = kf(0, ks);
#pragma unroll
    for (int kt = 0; kt < 4; ++kt) {
      if (kt + 1 < 4) {
#pragma unroll
        for (int ks = 0; ks < NKS; ++ks) kfr[(kt + 1) & 1][ks] = kf(kt + 1, ks);
      }
      __builtin_amdgcn_sched_barrier(0);
      s[0][kt] = cin(0, kt);
      s[1][kt] = cin(1, kt);
#pragma unroll
      for (int ks = 0; ks < NKS; ++ks) {
        s[0][kt] = MFMA(kfr[kt & 1][ks], qf[ks][0], s[0][kt]);
        s[1][kt] = MFMA(kfr[kt & 1][ks], qf[ks][1], s[1][kt]);
      }
    }
  }
  float mx[2];
#pragma unroll
  for (int qt = 0; qt < 2; ++qt) {
    float a = -INFINITY;
#pragma unroll
    for (int kt = 0; kt < 4; ++kt) a = fmaxf(a, fmaxf(fmaxf(s[qt][kt][0], s[qt][kt][1]), fmaxf(s[qt][kt][2], s[qt][kt][3])));
    mx[qt] = a;
  }
  const bool un0 = m[0] < -1e29f, un1 = m[1] < -1e29f;
  const bool need = (un0 ? (mx[0] > -INFINITY) : (mx[0] > FT_T)) || (un1 ? (mx[1] > -INFINITY) : (mx[1] > FT_T));
  if (__any(need)) {
#pragma unroll
    for (int qt = 0; qt < 2; ++qt) {
      float mq = mx[qt];
      mq = fmaxf(mq, __shfl_xor(mq, 16));
      mq = fmaxf(mq, __shfl_xor(mq, 32));
      const bool un = m[qt] < -1e29f;
      float delta = 0.f;
      if (un) {
        if (mq > -INFINITY) { delta = mq; m[qt] = mq; }
      } else if (mq > FT_T) {
        delta = mq;
        m[qt] += mq;
        const float sc = __builtin_amdgcn_exp2f(-mq);
        l[qt] *= sc;
        if (PV) {
#pragma unroll
          for (int dt = 0; dt < 4; ++dt) o[dt][qt] *= sc;
        }
      }
#pragma unroll
      for (int kt = 0; kt < 4; ++kt) s[qt][kt] -= delta;
    }
  }
  bf16x8 pb[2][2];
#pragma unroll
  for (int qt = 0; qt < 2; ++qt) {
    float ps = 0.f;
    float pv[4][4];
#pragma unroll
    for (int kt = 0; kt < 4; ++kt)
#pragma unroll
      for (int j = 0; j < 4; ++j) {
        float e = __builtin_amdgcn_exp2f(s[qt][kt][j]);
        pv[kt][j] = e;
        ps += e;
      }
    l[qt] += ps;
    ph(qt, pv);
    if (PV) {
#pragma unroll
      for (int kk = 0; kk < 2; ++kk) {
        U8 u;
        u.w[0] = pack2(pv[2 * kk][0], pv[2 * kk][1]);
        u.w[1] = pack2(pv[2 * kk][2], pv[2 * kk][3]);
        u.w[2] = pack2(pv[2 * kk + 1][0], pv[2 * kk + 1][1]);
        u.w[3] = pack2(pv[2 * kk + 1][2], pv[2 * kk + 1][3]);
        pb[qt][kk] = u.v;
      }
    }
  }
  if (PV) {
    bf16x8 vfr[2][4];
#pragma unroll
    for (int kk = 0; kk < 2; ++kk)
#pragma unroll
      for (int dt = 0; dt < 4; ++dt) vfr[kk][dt] = vf(dt, kk);
#pragma unroll
    for (int kk = 0; kk < 2; ++kk)
#pragma unroll
      for (int dt = 0; dt < 4; ++dt) {
        o[dt][0] = MFMA(vfr[kk][dt], pb[0][kk], o[dt][0]);
        o[dt][1] = MFMA(vfr[kk][dt], pb[1][kk], o[dt][1]);
      }
  }
}
template <bool MASK>
struct AlibiInit {
  float sl, off0, off1;
  int lim0, lim1, win;
  __device__ __forceinline__ f32x4 operator()(int qt, int kt) const {
    const float off = qt ? off1 : off0;
    const int lim = qt ? lim1 : lim0;
    f32x4 c;
#pragma unroll
    for (int j = 0; j < 4; ++j) {
      const int kj = kt * 16 + j;
      float v = __builtin_fmaf(sl, (float)kj, off);
      if (MASK) v = (kj <= lim && kj > lim - win) ? v : -INFINITY;
      c[j] = v;
    }
    return c;
  }
};
__device__ __forceinline__ float ft_shift(float m) { return m < -1e29f ? 0.f : -m; }

struct NoHook { __device__ __forceinline__ void operator()(int, float (&)[4][4]) const {} };

struct IdMap { __device__ __forceinline__ int operator()(int t) const { return t; } };
template <int NKC, class KS, class KD, class VS, class Fn, class TM = IdMap>
__device__ __forceinline__ void flash_loop(int tb, int te, KS ksrc, KD kdst, VS vsrc, u16* Ks, u16* Vs, Fn fn, TM tmap = IdMap()) {
  const int tid = TIDX();
  u32x4 rk[NKC], rv[2];
  if (tb < te) {
    const int tt = tmap(tb);
#pragma unroll
    for (int i = 0; i < NKC; ++i) rk[i] = *(GAS const u32x4*)ksrc(tt, tid + i * 256);
#pragma unroll
    for (int i = 0; i < 2; ++i) rv[i] = *(GAS const u32x4*)vsrc(tt, tid + i * 256);
  }
  for (int t = tb; t < te; ++t) {
    __syncthreads();
#pragma unroll
    for (int i = 0; i < NKC; ++i) *(u32x4*)(Ks + kdst(tid + i * 256)) = rk[i];
#pragma unroll
    for (int i = 0; i < 2; ++i) { int c = tid + i * 256; *(u32x4*)(Vs + (c >> 3) * 72 + (c & 7) * 8) = rv[i]; }
    __syncthreads();
    if (t + 1 < te) {
      const int tt = tmap(t + 1);
#pragma unroll
      for (int i = 0; i < NKC; ++i) rk[i] = *(GAS const u32x4*)ksrc(tt, tid + i * 256);
#pragma unroll
      for (int i = 0; i < 2; ++i) rv[i] = *(GAS const u32x4*)vsrc(tt, tid + i * 256);
    }
    fn(tmap(t));
  }
}

__device__ __forceinline__ void tr_tile(const float* __restrict__ src, int ldsrc, u16* __restrict__ dst, int K, int N,
                                        int kt, int nt, const float* __restrict__ scale, bool cmap, char* smem, int sklim = 1 << 30) {
  float* tile = (float*)smem;
  const int tid = TIDX();
  const int nn = tid & 63, np = nt * 64 + nn;
  int oc = np;
  if (cmap) { if (np >= 1024 && np < 3104) oc = np + 4; else if (np >= 3104 && np < 3108) oc = np - 2080; }
  const bool inr = np < N;
  const float* col = src + (inr ? oc : 0);
  const int k0 = kt * 64 + (tid >> 6);
  float vals[16];
#pragma unroll
  for (int i = 0; i < 16; ++i) vals[i] = col[(long)(k0 + i * 4) * ldsrc];
  if (scale) {
#pragma unroll
    for (int i = 0; i < 16; ++i) { const int k = k0 + i * 4; vals[i] *= (k < sklim) ? scale[k < sklim ? k : 0] : 1.f; }
  }
  __syncthreads();
#pragma unroll
  for (int i = 0; i < 16; ++i) tile[(i * 4 + (tid >> 6)) * 65 + nn] = inr ? vals[i] : 0.f;
  __syncthreads();
#pragma unroll 4
  for (int i = 0; i < 16; ++i) {
    int n2 = i * 4 + (tid >> 6), kk = tid & 63;
    dst[(long)(nt * 64 + n2) * K + kt * 64 + kk] = f2bf(tile[kk * 65 + n2]);
  }
}

constexpr int TR_ITEMS = 3448;
__device__ __forceinline__ void weights_item(const Params& p, int layer, int it, char* smem) {
  char* ws = WSP(p);
  if (it < 800) { tr_tile(INP(p, I_WIN) + (long)layer * 1024 * 3120, 3120, (u16*)(ws + OFF_WT_IN), 1024, 3120, it % 16, it / 16, nullptr, true, smem); return; }
  it -= 800;
  if (it < 256) { tr_tile(INP(p, I_WOUT) + (long)layer * 1024 * 1024, 1024, (u16*)(ws + OFF_WT_OUT), 1024, 1024, it % 16, it / 16, INP(p, I_SSMG) + layer * 256, false, smem, 256); return; }
  it -= 256;
  if (it < 1024) { tr_tile(INP(p, I_WM1) + (long)layer * 1024 * 4096, 4096, (u16*)(ws + OFF_WT_M1), 1024, 4096, it % 16, it / 16, nullptr, false, smem); return; }
  it -= 1024;
  if (it < 1024) { tr_tile(INP(p, I_WM2) + (long)layer * 4096 * 1024, 1024, (u16*)(ws + OFF_WT_M2), 4096, 1024, it % 64, it / 64, nullptr, false, smem); return; }
  it -= 1024;
  if (it < 24) { tr_tile(INP(p, I_WUQ) + (long)layer * 256 * 384, 384, (u16*)(ws + OFF_WT_UQ), 256, 384, it % 4, it / 4, INP(p, I_QNG) + layer * 256, false, smem); return; }
  it -= 24;
  if (it < 16) { tr_tile(INP(p, I_WUKV) + (long)layer * 128 * 512, 512, (u16*)(ws + OFF_WT_UKV), 128, 512, it % 2, it / 2, INP(p, I_KVNG) + layer * 128, false, smem); return; }
  it -= 16;
  if (it < 128) { tr_tile(INP(p, I_W1K) + (long)layer * 2048 * 256, 256, (u16*)(ws + OFF_WT_C1K), 2048, 256, it % 32, it / 32, nullptr, false, smem); return; }
  it -= 128;
  if (it < 128) { tr_tile(INP(p, I_W1V) + (long)layer * 2048 * 256, 256, (u16*)(ws + OFF_WT_C1V), 2048, 256, it % 32, it / 32, nullptr, false, smem); return; }
  it -= 128;
  if (it < 8) { tr_tile(INP(p, I_W2K) + (long)layer * 256 * 64, 64, (u16*)(ws + OFF_WT_C2K), 256, 64, it % 4, it / 4, nullptr, false, smem); return; }
  it -= 8;
  if (it < 8) { tr_tile(INP(p, I_W2V) + (long)layer * 256 * 64, 64, (u16*)(ws + OFF_WT_C2V), 256, 64, it % 4, it / 4, nullptr, false, smem); return; }
  it -= 8;
  {
    int job = it >> 4, sp = it & 15, n = TIDX();
    const float* pe = (job ? INP(p, I_PEV) : INP(p, I_PEK)) + (long)layer * 2048;
    const float* w1 = (job ? INP(p, I_W1V) : INP(p, I_W1K)) + (long)layer * 2048 * 256;
    float a = 0.f;
    for (int kk = sp * 128; kk < sp * 128 + 128; ++kk) a += pe[kk] * w1[(long)kk * 256 + n];
    ((float*)(ws + OFF_BIASP))[(job * 16 + sp) * 256 + n] = a;
  }
}

__device__ __forceinline__ void rope_item(const Params& p, int it) {
  const int tid = TIDX();
  const int pos = it * 16 + (tid >> 4), i = tid & 15;
  float* cm = (float*)(WSP(p) + OFF_COSM); float* sm = (float*)(WSP(p) + OFF_SINM);
  float* cr = (float*)(WSP(p) + OFF_COSR); float* sr = (float*)(WSP(p) + OFF_SINR);
  const float L2T = 13.287712379549449f;
  {
    float inv = exp2f(-(float)(2 * i) / 32.f * L2T);
    float ang = (float)pos * inv;
    double ad = (double)ang;
    float r = (float)(ad - 6.283185307179586 * rint(ad * 0.15915494309189535));
    cm[pos * 16 + i] = __cosf(r); sm[pos * 16 + i] = __sinf(r);
  }
#pragma unroll
  for (int e = 0; e < 2; ++e) {
    int ii = i + e * 16;
    float inv = exp2f(-(float)(2 * ii) / 64.f * L2T);
    float ang = (float)pos * inv;
    double ad = (double)ang;
    float r = (float)(ad - 6.283185307179586 * rint(ad * 0.15915494309189535));
    cr[pos * 32 + ii] = __cosf(r); sr[pos * 32 + ii] = __sinf(r);
  }
}

__device__ __forceinline__ void ln_row(const float* src, const float* __restrict__ g, const float* __restrict__ bb,
                                       float* dst32, u16* __restrict__ dstbf, int row, float* stats = nullptr) {
  const int lane = TIDX() & 63;
  const float4* s4 = (const float4*)(src + (long)row * 1024);
  float4 v[4];
#pragma unroll
  for (int i = 0; i < 4; ++i) v[i] = s4[lane + 64 * i];
  float sm = 0.f;
#pragma unroll
  for (int i = 0; i < 4; ++i) sm += v[i].x + v[i].y + v[i].z + v[i].w;
  const float mean = wave_sum(sm) * (1.f / 1024.f);
  float vs = 0.f;
#pragma unroll
  for (int i = 0; i < 4; ++i) {
    float a = v[i].x - mean, b = v[i].y - mean, c = v[i].z - mean, d = v[i].w - mean;
    vs += a * a + b * b + c * c + d * d;
  }
  const float rstd = rsqrtf(wave_sum(vs) * (1.f / 1024.f) + EPS_);
  float4* d4 = (float4*)(dst32 + (long)row * 1024);
  u32x2* db = (u32x2*)(dstbf + (long)row * 1024);
#pragma unroll
  for (int i = 0; i < 4; ++i) {
    float4 gg = ((const float4*)g)[lane + 64 * i], b4 = ((const float4*)bb)[lane + 64 * i], o;
    o.x = (v[i].x - mean) * rstd * gg.x + b4.x;
    o.y = (v[i].y - mean) * rstd * gg.y + b4.y;
    o.z = (v[i].z - mean) * rstd * gg.z + b4.z;
    o.w = (v[i].w - mean) * rstd * gg.w + b4.w;
    if (dst32) d4[lane + 64 * i] = o;
    u32x2 pk; pk.x = pack2(o.x, o.y); pk.y = pack2(o.z, o.w);
    db[lane + 64 * i] = pk;
  }
  if (stats && lane == 0) { stats[row * 2] = mean; stats[row * 2 + 1] = rstd; }
}

__device__ __forceinline__ void phase0(const Params& p, int bid, int nb, char* smem) {
  if (bid == 0 && TIDX() < 64) ((int*)(WSP(p) + OFF_CNT))[TIDX()] = 0;
  const int total = TR_ITEMS + 512 + 4096;
  for (int it = bid; it < total; it += nb) {
    if (it < TR_ITEMS) weights_item(p, 0, it, smem);
    else if (it < TR_ITEMS + 512) rope_item(p, it - TR_ITEMS);
    else {
      int row = (it - TR_ITEMS - 512) * 4 + (TIDX() >> 6);
      ln_row(INP(p, I_X), INP(p, I_LNEG), INP(p, I_LNEB), p.h32, (u16*)(WSP(p) + OFF_HBF), row);
    }
  }
}

__device__ __forceinline__ void phase_ln(const Params& p, int bid, int nb, char* smem, const float* g, const float* b, int conv_layer, int slot, bool final_out) {
  const int nconv = conv_layer >= 0 ? TR_ITEMS : 0;
  const int total = nconv + 4096;
  for (int it = bid; it < total; it += nb) {
    if (it < nconv) weights_item(p, conv_layer, it, smem);
    else {
      int row = (it - nconv) * 4 + (TIDX() >> 6);
      float* st = (float*)(WSP(p) + OFF_LNST) + (long)slot * T_ * 2;
      if (final_out) ln_row(p.h32, g, b, p.h32, (u16*)(WSP(p) + OFF_HBF), row);
      else ln_row(p.h32, g, b, nullptr, (u16*)(WSP(p) + OFF_HBF), row, st);
    }
  }
}

__device__ __forceinline__ int xcd_tile(int t, int bid, int nb, int ntiles) {
  if (nb & 7) return t;
  const int pass = t - bid;
  const int chunk = nb >> 3;
  const int r = (bid & 7) * chunk + (bid >> 3) + pass;
  return ((pass + nb) <= ntiles) ? r : t;
}

__device__ __forceinline__ void phase_inproj(const Params& p, int bid, int nb, char* smem) {
  const u16* A = (const u16*)(WSP(p) + OFF_HBF);
  const u16* Bt = (const u16*)(WSP(p) + OFF_WT_IN);
  u16* out = (u16*)(WSP(p) + OFF_R + R_PROJ);
  for (int t0 = bid; t0 < 128 * 25; t0 += nb) {
    const int t = xcd_tile(t0, bid, nb, 128 * 25);
    const int mt = t / 25, nt = t % 25;
    const int m0 = mt * 128, n0 = nt * 128;
    gemm_tile<true>([&](int r) { return A + (long)(m0 + r) * 1024; }, 64, Bt, 1024, 1024, n0,
              [&](int r, int c, const f32x4& v) {
                u32x2 pk; pk.x = pack2(v[0], v[1]); pk.y = pack2(v[2], v[3]);
                *(u32x2*)(out + (long)(m0 + r) * DINP_ + n0 + c) = pk;
              }, (u16*)smem);
  }
}

template <bool SSDNORM>
__device__ __forceinline__ void phase_resgemm(const Params& p, int bid, int nb, char* smem, const u16* A, int K, const u16* Bt,
                                              const float* lnst, const float* lng, const float* lnb) {
  float* h = p.h32;
  float* rstd = (float*)(smem + 65536);
  float* rowst = (float*)(smem + 65536 + 512);
  const float* ssq = (const float*)(WSP(p) + OFF_SSQ);
  for (int t0 = bid; t0 < 128 * 8; t0 += nb) {
    const int t = xcd_tile(t0, bid, nb, 128 * 8);
    const int mt = t / 8, nt = t % 8;
    const int m0 = mt * 128, n0 = nt * 128;
    if (SSDNORM) {
      __syncthreads();
      const int tid = TIDX();
      if (tid < 128) {
        const f32x4 s4 = *(const f32x4*)(ssq + (long)(m0 + tid) * 4);
        rstd[tid] = rsqrtf((s4[0] + s4[1] + s4[2] + s4[3]) * (1.f / 256.f) + EPS_);
      }
      __syncthreads();
    }
    if (lnst) {
      __syncthreads();
      const int tid = TIDX();
      rowst[tid] = lnst[(long)m0 * 2 + tid];
      __syncthreads();
    }
    gemm_tile<true>([&](int r) { return A + (long)(m0 + r) * K; }, 64, Bt, K, K, n0,
              [&](int r, int c, const f32x4& v) {
                f32x4* q = (f32x4*)(h + (long)(m0 + r) * 1024 + n0 + c);
                f32x4 res = *q;
                if (lnst) {
                  const float mu = rowst[r * 2], rs = rowst[r * 2 + 1];
                  const f32x4 g4 = *(const f32x4*)(lng + n0 + c), b4 = *(const f32x4*)(lnb + n0 + c);
                  res = (res - mu) * rs * g4 + b4;
                }
                *q = ALPHA_ * res + v;
              }, (u16*)smem,
              [&](int kt, f32x4 (&acc)[4][4]) {
                if (SSDNORM && kt == 3) {
                  const int tid = TIDX(), wm = tid >> 7, lr = tid & 15;
#pragma unroll
                  for (int mi = 0; mi < 4; ++mi) {
                    const float rs = rstd[wm * 64 + mi * 16 + lr];
#pragma unroll
                    for (int ni = 0; ni < 4; ++ni) acc[mi][ni] *= rs;
                  }
                }
              });
  }
}

__device__ __forceinline__ void phase_mlp1(const Params& p, int bid, int nb, char* smem) {
  const u16* A = (const u16*)(WSP(p) + OFF_HBF);
  const u16* Bt = (const u16*)(WSP(p) + OFF_WT_M1);
  u16* out = (u16*)(WSP(p) + OFF_R);
  for (int t0 = bid; t0 < 128 * 32; t0 += nb) {
    int mt, nt;
    if (nb == 512) {
      const int pass = t0 >> 9, x = bid & 7, j = bid >> 3;
      const int s = pass * 8 + x;
      mt = (s >> 2) * 8 + (j >> 3);
      nt = (s & 3) * 8 + (j & 7);
    } else {
      const int t = xcd_tile(t0, bid, nb, 128 * 32);
      mt = t / 32; nt = t % 32;
    }
    const int m0 = mt * 128, n0 = nt * 128;
    gemm_tile<true>([&](int r) { return A + (long)(m0 + r) * 1024; }, 64, Bt, 1024, 1024, n0,
              [&](int r, int c, const f32x4& v) {
                const float x0 = fmaxf(v[0], 0.f), x1 = fmaxf(v[1], 0.f), x2 = fmaxf(v[2], 0.f), x3 = fmaxf(v[3], 0.f);
                u32x2 pk; pk.x = pack2(x0 * x0, x1 * x1); pk.y = pack2(x2 * x2, x3 * x3);
                *(u32x2*)(out + (long)(m0 + r) * DFF_ + n0 + c) = pk;
              }, (u16*)smem);
  }
}

__device__ __forceinline__ void conv8(const u16* __restrict__ proj, const float* __restrict__ cw, const float* __restrict__ cb,
                                      int b, int pos, int ch0, float (&out)[8]) {
  float acc[8];
#pragma unroll
  for (int i = 0; i < 8; ++i) acc[i] = cb[ch0 + i];
  U8 v[4];
#pragma unroll
  for (int j = 0; j < 4; ++j) {
    const int pp = pos - 3 + j;
    v[j].u = *(const u32x4*)(proj + (long)(b * S_ + (pp > 0 ? pp : 0)) * DINP_ + C_XS + ch0);
  }
#pragma unroll
  for (int j = 0; j < 4; ++j) {
    const float mk = (pos - 3 + j) >= 0 ? 1.f : 0.f;
    const float* w = cw + j * 768 + ch0;
#pragma unroll
    for (int i = 0; i < 8; ++i) acc[i] += (w[i] * mk) * bf2f(v[j].s[i]);
  }
#pragma unroll
  for (int i = 0; i < 8; ++i) out[i] = silu_f(acc[i]);
}

__device__ __forceinline__ void ssd_dt_setup(const Params& p, int layer, int b, int c, int h, float* dtv, float* acs, float* tmp) {
  const int tid = TIDX(), lane = tid & 63;
  const u16* proj = PROJ(p);
  __syncthreads();
  float a = 0.f;
  if (tid < 128) {
    float raw = bf2f(proj[(long)(b * S_ + c * 128 + tid) * DINP_ + C_DT + h]) + INP(p, I_DTB)[layer * 4 + h];
    float dt = raw > 20.f ? raw : log1pf(__expf(raw));
    dtv[tid] = dt;
    a = -dt * __expf(INP(p, I_ALOG)[layer * 4 + h]);
#pragma unroll
    for (int ofs = 1; ofs < 64; ofs <<= 1) {
      const float v = __shfl_up(a, ofs);
      if (lane >= ofs) a += v;
    }
    if (tid == 63) tmp[0] = a;
  }
  __syncthreads();
  if (tid < 128) acs[tid] = (tid >= 64) ? a + tmp[0] : a;
  __syncthreads();
}

__device__ __forceinline__ void ssd_state_item(const Params& p, int layer, int item, char* smem) {
  const int b = item >> 8, c = (item >> 2) & 63, h = item & 3, g = h >> 1;
  const int tid = TIDX(), lane = tid & 63, wave = tid >> 6, lr = lane & 15, quad = lane >> 4;
  u16* Xt = (u16*)smem;
  u16* Btr = Xt + 64 * TSTR;
  float* dtv = (float*)(smem + (64 + 128) * TSTR * 2);
  float* acs = dtv + 128;
  float* tmp = acs + 128;
  const u16* proj = PROJ(p);
  const float* cw = INP(p, I_CONVW) + layer * 4 * 768;
  const float* cb = INP(p, I_CONVB) + layer * 768;
  ssd_dt_setup(p, layer, b, c, h, dtv, acs, tmp);
  const float aend = acs[127];
#pragma unroll 2
  for (int i = 0; i < 4; ++i) {
    int cc = tid + i * 256, l = cc >> 3, p0 = (cc & 7) * 8;
    float o[8];
    conv8(proj, cw, cb, b, c * 128 + l, h * 64 + p0, o);
    const float w = dtv[l] * __expf(aend - acs[l]);
#pragma unroll
    for (int e = 0; e < 8; ++e) Xt[(p0 + e) * TSTR + l] = f2bf(o[e] * w);
  }
#pragma unroll 2
  for (int i = 0; i < 8; ++i) {
    int cc = tid + i * 256, l = cc >> 4, n0 = (cc & 15) * 8;
    float o[8];
    conv8(proj, cw, cb, b, c * 128 + l, 256 + g * 128 + n0, o);
#pragma unroll
    for (int e = 0; e < 8; ++e) Btr[(n0 + e) * TSTR + l] = f2bf(o[e]);
  }
  __syncthreads();
  f32x4 acc[4][2];
#pragma unroll
  for (int mi = 0; mi < 4; ++mi) { acc[mi][0] = (f32x4){0.f, 0.f, 0.f, 0.f}; acc[mi][1] = (f32x4){0.f, 0.f, 0.f, 0.f}; }
#pragma unroll
  for (int ks = 0; ks < 4; ++ks) {
    bf16x8 bb[2];
#pragma unroll
    for (int ni = 0; ni < 2; ++ni) bb[ni] = *(const bf16x8*)(Btr + (wave * 32 + ni * 16 + lr) * TSTR + ks * 32 + quad * 8);
#pragma unroll
    for (int mi = 0; mi < 4; ++mi) {
      bf16x8 a = *(const bf16x8*)(Xt + (mi * 16 + lr) * TSTR + ks * 32 + quad * 8);
      acc[mi][0] = MFMA(a, bb[0], acc[mi][0]);
      acc[mi][1] = MFMA(a, bb[1], acc[mi][1]);
    }
  }
  float* st = (float*)(WSP(p) + OFF_R + R_SSDST) + (long)((b * 64 + c) * 4 + h) * 8192;
#pragma unroll
  for (int mi = 0; mi < 4; ++mi)
#pragma unroll
    for (int ni = 0; ni < 2; ++ni)
#pragma unroll
      for (int j = 0; j < 4; ++j) st[(mi * 16 + quad * 4 + j) * 128 + wave * 32 + ni * 16 + lr] = acc[mi][ni][j];
  if (tid == 0) ((float*)(WSP(p) + OFF_SSDDEC))[(b * 64 + c) * 4 + h] = __expf(aend);
}

__device__ __forceinline__ void ret_rope8(const Params& p, const u16* __restrict__ proj, int col, int b, int pos, int d0, float scale, float (&out)[8]) {
  const u16* row = proj + (long)(b * S_ + pos) * DINP_ + col;
  const int i0 = d0 & 31;
  U8 x1, x2;
  x1.u = *(const u32x4*)(row + i0);
  x2.u = *(const u32x4*)(row + 32 + i0);
  const float* cr = (const float*)(WSP(p) + OFF_COSR) + pos * 32 + i0;
  const float* sr = (const float*)(WSP(p) + OFF_SINR) + pos * 32 + i0;
#pragma unroll
  for (int e = 0; e < 8; ++e) {
    float a = bf2f(x1.s[e]), bb = bf2f(x2.s[e]), cc = cr[e], ss = sr[e];
    out[e] = (d0 < 32 ? (a * cc - bb * ss) : (a * ss + bb * cc)) * scale;
  }
}

__device__ __forceinline__ float ret_loggamma(int h) { return log1pf(-exp2f(-5.f - (float)h)); }

__device__ __forceinline__ void ret_state_item(const Params& p, int layer, int item, char* smem) {
  const int b = item >> 8, c = (item >> 2) & 63, h = item & 3;
  const int tid = TIDX(), lane = tid & 63, wave = tid >> 6, lr = lane & 15, quad = lane >> 4;
  u16* Vt = (u16*)smem;
  u16* Kt = Vt + 64 * TSTR;
  const u16* proj = PROJ(p);
  const float lg = ret_loggamma(h);
  __syncthreads();
#pragma unroll 2
  for (int i = 0; i < 4; ++i) {
    int cc = tid + i * 256, l = cc >> 3, v0 = (cc & 7) * 8;
    U8 x; x.u = *(const u32x4*)(proj + (long)(b * S_ + c * 128 + l) * DINP_ + C_RV + h * 64 + v0);
    const float z = __expf((float)(127 - l) * lg);
#pragma unroll
    for (int e = 0; e < 8; ++e) Vt[(v0 + e) * TSTR + l] = f2bf(bf2f(x.s[e]) * z);
  }
#pragma unroll 2
  for (int i = 0; i < 4; ++i) {
    int cc = tid + i * 256, l = cc >> 3, d0 = (cc & 7) * 8;
    float o[8];
    ret_rope8(p, proj, C_RK + h * 64, b, c * 128 + l, d0, 0.125f, o);
#pragma unroll
    for (int e = 0; e < 8; ++e) Kt[(d0 + e) * TSTR + l] = f2bf(o[e]);
  }
  __syncthreads();
  f32x4 acc[4];
#pragma unroll
  for (int mi = 0; mi < 4; ++mi) acc[mi] = (f32x4){0.f, 0.f, 0.f, 0.f};
#pragma unroll
  for (int ks = 0; ks < 4; ++ks) {
    bf16x8 bb = *(const bf16x8*)(Kt + (wave * 16 + lr) * TSTR + ks * 32 + quad * 8);
#pragma unroll
    for (int mi = 0; mi < 4; ++mi) {
      bf16x8 a = *(const bf16x8*)(Vt + (mi * 16 + lr) * TSTR + ks * 32 + quad * 8);
      acc[mi] = MFMA(a, bb, acc[mi]);
    }
  }
  float* st = (float*)(WSP(p) + OFF_R + R_RETST) + (long)((b * 64 + c) * 4 + h) * 4096;
#pragma unroll
  for (int mi = 0; mi < 4; ++mi)
#pragma unroll
    for (int j = 0; j < 4; ++j) st[(mi * 16 + quad * 4 + j) * 64 + wave * 16 + lr] = acc[mi][j];
}

__device__ __forceinline__ void mla_up_item(const Params& p, int which, int t, char* smem) {
  const int tid = TIDX();
  const u16* proj = PROJ(p);
  float* rstd = (float*)(smem + 65536);
  const int K = which ? 128 : 256, nnt = which ? 4 : 3;
  const int mt = t / nnt, nt = t % nnt, m0 = mt * 128, n0 = nt * 128;
  const int col = which ? C_CKV : C_CQ;
  __syncthreads();
  {
    const int r = tid >> 1, hf = tid & 1, n = K / 2;
    const u16* src = proj + (long)(m0 + r) * DINP_ + col + hf * n;
    float ss = 0.f;
    for (int i = 0; i < n; i += 8) {
      U8 x; x.u = *(const u32x4*)(src + i);
#pragma unroll
      for (int e = 0; e < 8; ++e) { float f = bf2f(x.s[e]); ss += f * f; }
    }
    ss += __shfl_xor(ss, 1);
    if (hf == 0) rstd[r] = rsqrtf(ss / (float)K + EPS_);
  }
  __syncthreads();
  if (which == 0) {
    u16* q = (u16*)(WSP(p) + OFF_QMLA);
    const float sc = 0.10206207261596575f * 1.4426950408889634f;
    gemm_tile<true>([&](int r) { return proj + (long)(m0 + r) * DINP_ + col; }, 64, (const u16*)(WSP(p) + OFF_WT_UQ), 256, 256, n0,
              [&](int r, int c, const f32x4& v) {
                const float rs = rstd[r] * sc;
                u32x2 pk; pk.x = pack2(v[0] * rs, v[1] * rs); pk.y = pack2(v[2] * rs, v[3] * rs);
                *(u32x2*)(q + (long)(m0 + r) * 384 + n0 + c) = pk;
              }, (u16*)smem);
  } else {
    u16* kb = (u16*)(WSP(p) + OFF_KBUF);
    u16* vt = (u16*)(WSP(p) + OFF_VTMLA);
    gemm_tile<false>([&](int r) { return proj + (long)(m0 + r) * DINP_ + col; }, 64, (const u16*)(WSP(p) + OFF_WT_UKV), 128, 128, n0,
              [&](int r, int c, const f32x4& v) {
                const int n = n0 + c, hh = n >> 7, d = n & 127;
                if (d < 64) {
#pragma unroll
                  for (int j = 0; j < 4; ++j) kb[(long)(m0 + r + j) * 384 + hh * 96 + d] = f2bf(v[j] * rstd[r + j]);
                } else {
                  const int tok = m0 + r, bb = tok >> 13, pos = tok & 8191;
                  u32x2 pk;
                  pk.x = pack2(v[0] * rstd[r], v[1] * rstd[r + 1]);
                  pk.y = pack2(v[2] * rstd[r + 2], v[3] * rstd[r + 3]);
                  *(u32x2*)(vt + ((long)(bb * 4 + hh) * 64 + (d - 64)) * 8192 + pos) = pk;
                }
              }, (u16*)smem);
  }
}

__device__ __forceinline__ void kpe_item(const Params& p, int it) {
  const int tid = TIDX();
  const u16* proj = PROJ(p);
  u16* kb = (u16*)(WSP(p) + OFF_KBUF);
  const float* cm = (const float*)(WSP(p) + OFF_COSM);
  const float* sm = (const float*)(WSP(p) + OFF_SINM);
#pragma unroll 4
  for (int e = 0; e < 8; ++e) {
    int idx = tid + e * 256;
    int tok = it * 128 + (idx >> 4), i = idx & 15, pos = tok & 8191;
    const u16* row = proj + (long)tok * DINP_ + C_KR;
    float x1 = bf2f(row[i]), x2 = bf2f(row[16 + i]);
    float c = cm[pos * 16 + i], s = sm[pos * 16 + i];
    u16 y1 = f2bf(x1 * c - x2 * s), y2 = f2bf(x1 * s + x2 * c);
#pragma unroll
    for (int hh = 0; hh < 4; ++hh) { kb[(long)tok * 384 + hh * 96 + 64 + i] = y1; kb[(long)tok * 384 + hh * 96 + 80 + i] = y2; }
  }
}

__device__ __forceinline__ void vtrans_item(const Params& p, int it, char* smem) {
  const int which = it >> 8, blk = it & 255, b = blk >> 7, t0 = (blk & 127) * 64;
  const int tid = TIDX();
  const u16* proj = PROJ(p);
  u16* tile = (u16*)smem;
  u16* dst = (u16*)(WSP(p) + (which ? OFF_VWT : OFF_VST));
  const int col = which ? C_NVW : C_NVS;
  __syncthreads();
#pragma unroll
  for (int i = 0; i < 2; ++i) {
    int c = tid + i * 256, tok = c >> 3, ch = c & 7;
    *(u32x4*)(tile + tok * 72 + ch * 8) = *(const u32x4*)(proj + (long)(b * S_ + t0 + tok) * DINP_ + col + ch * 8);
  }
  __syncthreads();
#pragma unroll
  for (int i = 0; i < 2; ++i) {
    int c = tid + i * 256, d = c >> 3, tch = c & 7;
    U8 o;
#pragma unroll
    for (int e = 0; e < 8; ++e) o.s[e] = tile[(tch * 8 + e) * 72 + d];
    *(u32x4*)(dst + (long)(b * 64 + d) * 8192 + t0 + tch * 8) = o.u;
  }
}

__device__ __forceinline__ void cmp_hid_item(const Params& p, int t, char* smem) {
  const int job = t >> 4, mt = (t >> 1) & 7, nt = t & 1, m0 = mt * 128, n0 = nt * 128;
  const u16* proj = PROJ(p);
  const int col = job ? C_NVC : C_NKC;
  u16* hid = (u16*)(WSP(p) + OFF_R + R_HID) + (long)job * 1024 * 256;
  const float* bp = (const float*)(WSP(p) + OFF_BIASP) + job * 16 * 256;
  float* bl = (float*)(smem + 65536);
  __syncthreads();
  if (TIDX() < 128) {
    float bias = 0.f;
#pragma unroll
    for (int s = 0; s < 16; ++s) bias += bp[s * 256 + n0 + TIDX()];
    bl[TIDX()] = bias;
  }
  __syncthreads();
  gemm_tile<true>([&](int r) { int rr = m0 + r; return proj + (long)((rr >> 9) * S_ + (rr & 511) * 16) * DINP_ + col; }, DINP_,
            (const u16*)(WSP(p) + (job ? OFF_WT_C1V : OFF_WT_C1K)), 2048, 2048, n0,
            [&](int r, int c, const f32x4& v) {
              const f32x4 b4 = *(const f32x4*)(bl + c);
              u32x2 pk;
              pk.x = pack2(silu_f(v[0] + b4[0]), silu_f(v[1] + b4[1]));
              pk.y = pack2(silu_f(v[2] + b4[2]), silu_f(v[3] + b4[3]));
              *(u32x2*)(hid + (long)(m0 + r) * 256 + n0 + c) = pk;
            }, (u16*)smem);
}

__device__ __forceinline__ int next_item_xcd(int* cnt8, int per, int& qx, char* smem) {
  int* sh = (int*)(smem + SMEM_BYTES - 16);
  __syncthreads();
  if (TIDX() == 0) {
    int res = -1;
    const int x0 = (int)blockIdx.x & 7;
    int d = atomicAdd(cnt8 + x0, 1);
    if (d < per) res = x0 * 65536 + d;
    else {
      int c[8];
#pragma unroll
      for (int s = 0; s < 8; ++s) c[s] = __hip_atomic_load(cnt8 + s, __ATOMIC_RELAXED, __HIP_MEMORY_SCOPE_AGENT);
#pragma unroll
      for (int s = 1; s < 8; ++s) {
        const int x = (x0 + s) & 7;
        int cx = 0;
#pragma unroll
        for (int q = 0; q < 8; ++q) cx = (q == x) ? c[q] : cx;
        if (res < 0 && cx < per) { d = atomicAdd(cnt8 + x, 1); if (d < per) res = x * 65536 + d; }
      }
    }
    *sh = res;
  }
  __syncthreads();
  const int r = *sh;
  qx = r >> 16;
  return r < 0 ? -1 : (r & 65535);
}
#define QLOOP_X(C8, PER, CALL)                                            \
  for (;;) {                                                              \
    int qx;                                                               \
    const int qd = next_item_xcd(cnt + (C8), (PER), qx, smem);            \
    if (qd < 0) break;                                                    \
    CALL;                                                                 \
  }
#define QLOOP(CIDX, N, CALL)                                              \
  for (;;) {                                                              \
    const int it = next_item(cnt + (CIDX), smem);                         \
    if (it >= (N)) break;                                                 \
    CALL;                                                                 \
  }
__device__ __forceinline__ void phase2(const Params& p, int layer, char* smem) {
  int* cnt = (int*)(WSP(p) + OFF_CNT) + layer * 16;
  QLOOP(0, 32, cmp_hid_item(p, it, smem))
  QLOOP(1, 512, ssd_state_item(p, layer, it, smem))
  QLOOP(2, 512, ret_state_item(p, layer, it, smem))
  QLOOP(3, 384, mla_up_item(p, 0, it, smem))
  QLOOP(4, 512, mla_up_item(p, 1, it, smem))
  QLOOP(5, 128, kpe_item(p, it))
  QLOOP(6, 512, vtrans_item(p, it, smem))
}


struct MlaTab { unsigned char qb[160], c[160]; };
constexpr MlaTab make_mla_tab() {
  MlaTab t{};
  int n = 0;
  for (int qb = 63; qb >= 0; --qb) { const int nt = 2 * qb + 2; for (int c = 0; c < nt / 32; ++c) { t.qb[n] = (unsigned char)qb; t.c[n] = (unsigned char)c; ++n; } }
  for (int rem = 30; rem >= 2; rem -= 2)
    for (int qb = 63; qb >= 0; --qb) { const int nt = 2 * qb + 2; if (nt % 32 == rem) { t.qb[n] = (unsigned char)qb; t.c[n] = (unsigned char)(nt / 32); ++n; } }
  return t;
}
__device__ const MlaTab g_mla_tab = make_mla_tab();
__device__ __forceinline__ int mla_slot(int bh, int qb, int c) { const int k = qb >> 4, r = qb & 15; return bh * 160 + 8 * k * (k + 1) + r * (k + 1) + c; }

__device__ __forceinline__ void mla_item(const Params& p, int item, char* smem) {
  const int un = item >> 3, bh = item & 7, b = bh >> 2, h = bh & 3;
  const int qb = g_mla_tab.qb[un], ch = g_mla_tab.c[un];
  const int tid = TIDX(), lane = tid & 63, wave = tid >> 6, lr = lane & 15, quad = lane >> 4;
  u16* Ks = (u16*)smem;
  u16* Vs = Ks + 64 * 104;
  const u16* qm = (const u16*)(WSP(p) + OFF_QMLA);
  const u16* kb = (const u16*)(WSP(p) + OFF_KBUF);
  const u16* vt = (const u16*)(WSP(p) + OFF_VTMLA) + (long)(b * 4 + h) * 64 * 8192;
  const float* cm = (const float*)(WSP(p) + OFF_COSM);
  const float* sm = (const float*)(WSP(p) + OFF_SINM);
  int tq[2];
  bf16x8 qf[3][2];
#pragma unroll
  for (int qt = 0; qt < 2; ++qt) {
    tq[qt] = qb * 128 + wave * 32 + qt * 16 + lr;
    const u16* qrow = qm + (long)(b * S_ + tq[qt]) * 384 + h * 96;
    qf[0][qt] = *(const bf16x8*)(qrow + quad * 8);
    qf[1][qt] = *(const bf16x8*)(qrow + 32 + quad * 8);
    U8 x, xp, o;
    x.u = *(const u32x4*)(qrow + 64 + quad * 8);
    xp.u = *(const u32x4*)(qrow + 64 + (quad ^ 2) * 8);
    const int i0 = (quad & 1) * 8;
#pragma unroll
    for (int e = 0; e < 8; ++e) {
      float c = cm[tq[qt] * 16 + i0 + e], s = sm[tq[qt] * 16 + i0 + e];
      float a = bf2f(x.s[e]), bb = bf2f(xp.s[e]);
      o.s[e] = f2bf(quad < 2 ? (a * c - bb * s) : (bb * s + a * c));
    }
    qf[2][qt] = o.v;
  }
  f32x4 o[4][2];
#pragma unroll
  for (int dt = 0; dt < 4; ++dt) { o[dt][0] = (f32x4){0.f, 0.f, 0.f, 0.f}; o[dt][1] = (f32x4){0.f, 0.f, 0.f, 0.f}; }
  float m[2] = {-1e30f, -1e30f}, l[2] = {0.f, 0.f};
  const int nt = 2 * qb + 2, nch = (nt + 31) >> 5;
  const int tb = ch * 32, te = (tb + 32 < nt) ? tb + 32 : nt;
  auto kf = [&](int kt, int ks) { return *(const bf16x8*)(Ks + (kt * 16 + lr) * 104 + ks * 32 + quad * 8); };
  auto vf = [&](int dt, int kk) {
    U8 u;
    u.d[0] = *(const u64*)(Vs + (dt * 16 + lr) * 72 + kk * 32 + quad * 4);
    u.d[1] = *(const u64*)(Vs + (dt * 16 + lr) * 72 + kk * 32 + 16 + quad * 4);
    return u.v;
  };
  flash_loop<3>(tb, te,
      [&](int t, int c) { int key = c / 12, cc = c % 12; return kb + (long)(b * S_ + t * 64 + key) * 384 + h * 96 + cc * 8; },
      [&](int c) { int key = c / 12, cc = c % 12; return key * 104 + cc * 8; },
      [&](int t, int c) { return vt + (long)(c >> 3) * 8192 + t * 64 + (c & 7) * 8; },
      Ks, Vs,
      [&](int t) {
        if (t == nt - 1 && wave < 2) return;
        const float sh0 = ft_shift(m[0]), sh1 = ft_shift(m[1]);
        if (t >= nt - 2) {
          const int lim0 = tq[0] - t * 64 - quad * 4, lim1 = tq[1] - t * 64 - quad * 4;
          flash_tile2<3, true>(kf, vf, [=](int qt, int kt) {
            const int lim = qt ? lim1 : lim0;
            const float sh = qt ? sh1 : sh0;
            f32x4 c;
#pragma unroll
            for (int j = 0; j < 4; ++j) c[j] = (kt * 16 + j <= lim) ? sh : -INFINITY;
            return c;
          }, NoHook(), qf, o, m, l);
        } else {
          flash_tile2<3, true>(kf, vf, [=](int qt, int) { const float sh = qt ? sh1 : sh0; return (f32x4){sh, sh, sh, sh}; }, NoHook(), qf, o, m, l);
        }
      });
  u16* mix = (u16*)(WSP(p) + OFF_HBF);
  const int slot = mla_slot(bh, qb, ch);
  u16* pO = (u16*)(WSP(p) + OFF_MLAP) + (long)slot * 8192;
  float* pML = (float*)(WSP(p) + OFF_MLAML) + (long)slot * 256;
#pragma unroll
  for (int qt = 0; qt < 2; ++qt) {
    float lt = l[qt];
    lt += __shfl_xor(lt, 16);
    lt += __shfl_xor(lt, 32);
    const float inv = 1.f / lt;
    const int ql = wave * 32 + qt * 16 + lr;
    u16* orow = (nch == 1) ? mix + (long)(b * S_ + tq[qt]) * 1024 + 256 + h * 64 : pO + ql * 64;
#pragma unroll
    for (int dt = 0; dt < 4; ++dt) {
      u32x2 pk;
      pk.x = pack2(o[dt][qt][0] * inv, o[dt][qt][1] * inv);
      pk.y = pack2(o[dt][qt][2] * inv, o[dt][qt][3] * inv);
      *(u32x2*)(orow + dt * 16 + quad * 4) = pk;
    }
    if (nch > 1 && quad == 0) { pML[ql * 2] = m[qt]; pML[ql * 2 + 1] = lt; }
  }
}

__device__ __forceinline__ void mla_combine_item(const Params& p, int ci) {
  const int bh = ci & 7, qb = 63 - (ci >> 3), b = bh >> 2, h = bh & 3;
  const int nch = (2 * qb + 2 + 31) >> 5;
  const int tid = TIDX(), q = tid >> 1, hf = tid & 1;
  const int slot0 = mla_slot(bh, qb, 0);
  const u16* pO = (const u16*)(WSP(p) + OFF_MLAP) + (long)slot0 * 8192 + q * 64 + hf * 32;
  const float* pML = (const float*)(WSP(p) + OFF_MLAML) + (long)slot0 * 256 + q * 2;
  float mc[4], lc[4], M = -1e30f;
#pragma unroll
  for (int c = 0; c < 4; ++c) {
    mc[c] = -1e30f; lc[c] = 0.f;
    if (c < nch) { mc[c] = pML[c * 256]; lc[c] = pML[c * 256 + 1]; }
    M = fmaxf(M, mc[c]);
  }
  float w[4], W = 0.f;
#pragma unroll
  for (int c = 0; c < 4; ++c) { w[c] = (c < nch) ? __builtin_amdgcn_exp2f(mc[c] - M) * lc[c] : 0.f; W += w[c]; }
  const float iW = 1.f / W;
  float acc[32];
#pragma unroll
  for (int e = 0; e < 32; ++e) acc[e] = 0.f;
#pragma unroll
  for (int c = 0; c < 4; ++c) {
    if (c < nch) {
      const float wc = w[c] * iW;
#pragma unroll
      for (int g = 0; g < 4; ++g) {
        U8 x; x.u = *(const u32x4*)(pO + (long)c * 8192 + g * 8);
#pragma unroll
        for (int e = 0; e < 8; ++e) acc[g * 8 + e] += wc * bf2f(x.s[e]);
      }
    }
  }
  u16* orow = (u16*)(WSP(p) + OFF_HBF) + (long)(b * S_ + qb * 128 + q) * 1024 + 256 + h * 64 + hf * 32;
#pragma unroll
  for (int g = 0; g < 4; ++g) {
    U8 o;
#pragma unroll
    for (int e = 0; e < 4; ++e) o.w[e] = pack2(acc[g * 8 + 2 * e], acc[g * 8 + 2 * e + 1]);
    *(u32x4*)(orow + g * 8) = o.u;
  }
}

__device__ __forceinline__ void cmp_out_item(const Params& p, int t, char* smem) {
  const int job = t >> 3, mt = t & 7, m0 = mt * 128;
  const u16* hid = (const u16*)(WSP(p) + OFF_R + R_HID) + (long)job * 1024 * 256;
  u16* kc = (u16*)(WSP(p) + OFF_R + R_KCMP);
  u16* vct = (u16*)(WSP(p) + OFF_R + R_VCT);
  gemm_tile<false>([&](int r) { return hid + (long)(m0 + r) * 256; }, 64, (const u16*)(WSP(p) + (job ? OFF_WT_C2V : OFF_WT_C2K)), 256, 256, 0,
            [&](int r, int c, const f32x4& v) {
              if (c < 64) {
                if (job == 0) {
#pragma unroll
                  for (int j = 0; j < 4; ++j) kc[(long)(m0 + r + j) * 64 + c] = f2bf(v[j]);
                } else {
                  const int rr = m0 + r, bb = rr >> 9, i = rr & 511;
                  u32x2 pk; pk.x = pack2(v[0], v[1]); pk.y = pack2(v[2], v[3]);
                  *(u32x2*)(vct + (long)(bb * 64 + c) * 512 + i) = pk;
                }
              }
            }, (u16*)smem);
}

__device__ __forceinline__ void scan_item(const Params& p, int it) {
  const int tid = TIDX();
  if (it < 256) {
    const int e = it * 256 + tid, b = e >> 15, h = (e >> 13) & 3, pn = e & 8191;
    float* st = (float*)(WSP(p) + OFF_R + R_SSDST) + (long)(b * 64 * 4 + h) * 8192 + pn;
    const float* dec = (const float*)(WSP(p) + OFF_SSDDEC) + b * 64 * 4 + h;
    float run = 0.f;
#pragma unroll 1
    for (int c0 = 0; c0 < 64; c0 += 16) {
      float s[16], d[16];
#pragma unroll
      for (int i = 0; i < 16; ++i) { s[i] = st[(long)(c0 + i) * 4 * 8192]; d[i] = dec[(c0 + i) * 4]; }
#pragma unroll
      for (int i = 0; i < 16; ++i) { const float prev = run; run = run * d[i] + s[i]; s[i] = prev; }
#pragma unroll
      for (int i = 0; i < 16; ++i) st[(long)(c0 + i) * 4 * 8192] = s[i];
    }
  } else {
    const int e = (it - 256) * 256 + tid, b = e >> 14, h = (e >> 12) & 3, vd = e & 4095;
    float* st = (float*)(WSP(p) + OFF_R + R_RETST) + (long)(b * 64 * 4 + h) * 4096 + vd;
    const float d = __expf(128.f * ret_loggamma(h));
    float run = 0.f;
#pragma unroll 1
    for (int c0 = 0; c0 < 64; c0 += 16) {
      float s[16];
#pragma unroll
      for (int i = 0; i < 16; ++i) s[i] = st[(long)(c0 + i) * 4 * 4096];
#pragma unroll
      for (int i = 0; i < 16; ++i) { const float prev = run; run = run * d + s[i]; s[i] = prev; }
#pragma unroll
      for (int i = 0; i < 16; ++i) st[(long)(c0 + i) * 4 * 4096] = s[i];
    }
  }
}

__device__ __forceinline__ void phase3(const Params& p, int layer, char* smem) {
  int* cnt = (int*)(WSP(p) + OFF_CNT) + layer * 16;
  QLOOP(7, 1280, mla_item(p, it, smem))
  QLOOP(8, 16, cmp_out_item(p, it, smem))
  QLOOP(9, 384, scan_item(p, it))
}

__device__ __forceinline__ void ssd_out_item(const Params& p, int layer, int item, char* smem) {
  const int b = item >> 8, c = (item >> 2) & 63, h = item & 3;
  const int tid = TIDX(), lane = tid & 63, wave = tid >> 6, lr = lane & 15, quad = lane >> 4;
  u16* Bs = (u16*)smem;
  u16* Xt = Bs + 128 * TSTR;
  u16* Sc = Xt + 64 * TSTR;
  float* dtv = (float*)(smem + (128 + 64 + 64) * TSTR * 2);
  float* acs = dtv + 128;
  float* tmp = acs + 128;
  float* ssq = tmp + 128;
  const u16* proj = PROJ(p);
  u16* mix = (u16*)(WSP(p) + OFF_HBF);
  const float* cw = INP(p, I_CONVW) + layer * 4 * 768;
  const float* cb = INP(p, I_CONVB) + layer * 768;
  float* ssqg = (float*)(WSP(p) + OFF_SSQ);
  (void)ssq;
  {
    const int g = h >> 1;
    ssd_dt_setup(p, layer, b, c, h, dtv, acs, tmp);
#pragma unroll 2
    for (int i = 0; i < 8; ++i) {
      int cc = tid + i * 256, l = cc >> 4, n0 = (cc & 15) * 8;
      float o[8];
      conv8(proj, cw, cb, b, c * 128 + l, 256 + g * 128 + n0, o);
      U8 u;
#pragma unroll
      for (int e = 0; e < 4; ++e) u.w[e] = pack2(o[2 * e], o[2 * e + 1]);
      *(u32x4*)(Bs + l * TSTR + n0) = u.u;
    }
#pragma unroll 2
    for (int i = 0; i < 4; ++i) {
      int cc = tid + i * 256, l = cc >> 3, p0 = (cc & 7) * 8;
      float o[8];
      conv8(proj, cw, cb, b, c * 128 + l, h * 64 + p0, o);
#pragma unroll
      for (int e = 0; e < 8; ++e) Xt[(p0 + e) * TSTR + l] = f2bf(o[e]);
    }
    __syncthreads();
    const float dsk = INP(p, I_DSKIP)[layer * 4 + h];
    const float* prev = (const float*)(WSP(p) + OFF_R + R_SSDST) + (long)((b * 64 + c) * 4 + h) * 8192;
#pragma unroll 1
    for (int pass = 0; pass < 2; ++pass) {
      const int row0 = pass * 64 + wave * 16;
      const int nlim = pass * 4 + wave + 1;
      bf16x8 cf[4];
#pragma unroll
      for (int ks = 0; ks < 4; ++ks) {
        float o[8];
        conv8(proj, cw, cb, b, c * 128 + row0 + lr, 512 + g * 128 + ks * 32 + quad * 8, o);
        U8 u;
#pragma unroll
        for (int e = 0; e < 4; ++e) u.w[e] = pack2(o[2 * e], o[2 * e + 1]);
        cf[ks] = u.v;
      }
#pragma unroll
      for (int ni = 0; ni < 8; ++ni) {
        if (ni < nlim) {
          f32x4 ga = (f32x4){0.f, 0.f, 0.f, 0.f};
#pragma unroll
          for (int ks = 0; ks < 4; ++ks) {
            bf16x8 bb = *(const bf16x8*)(Bs + (ni * 16 + lr) * TSTR + ks * 32 + quad * 8);
            ga = MFMA(cf[ks], bb, ga);
          }
          const int s = ni * 16 + lr;
          const float as = acs[s], ds = dtv[s];
#pragma unroll
          for (int j = 0; j < 4; ++j) {
            const int l = row0 + quad * 4 + j;
            float v = (s <= l) ? ga[j] * __expf(acs[l] - as) * ds : 0.f;
            Sc[(wave * 16 + quad * 4 + j) * TSTR + s] = f2bf(v);
          }
        } else if (ni == nlim) {
#pragma unroll
          for (int j = 0; j < 4; ++j) Sc[(wave * 16 + quad * 4 + j) * TSTR + ni * 16 + lr] = 0;
        }
      }
      f32x4 y[4];
#pragma unroll
      for (int ni = 0; ni < 4; ++ni) y[ni] = (f32x4){0.f, 0.f, 0.f, 0.f};
#pragma unroll
      for (int ks = 0; ks < 4; ++ks)
#pragma unroll
        for (int ni = 0; ni < 4; ++ni) {
          const float4* pp = (const float4*)(prev + (ni * 16 + lr) * 128 + ks * 32 + quad * 8);
          float4 f0 = pp[0], f1 = pp[1];
          U8 u;
          u.w[0] = pack2(f0.x, f0.y); u.w[1] = pack2(f0.z, f0.w); u.w[2] = pack2(f1.x, f1.y); u.w[3] = pack2(f1.z, f1.w);
          y[ni] = MFMA(cf[ks], u.v, y[ni]);
        }
#pragma unroll
      for (int j = 0; j < 4; ++j) {
        const float e = __expf(acs[row0 + quad * 4 + j]);
#pragma unroll
        for (int ni = 0; ni < 4; ++ni) y[ni][j] *= e;
      }
      asm volatile("s_waitcnt lgkmcnt(0)" ::: "memory");
#pragma unroll
      for (int ks = 0; ks < 4; ++ks) {
        if (ks * 2 < nlim) {
          bf16x8 a0 = *(const bf16x8*)(Sc + (wave * 16 + lr) * TSTR + ks * 32 + quad * 8);
#pragma unroll
          for (int ni = 0; ni < 4; ++ni) {
            bf16x8 bb = *(const bf16x8*)(Xt + (ni * 16 + lr) * TSTR + ks * 32 + quad * 8);
            y[ni] = MFMA(a0, bb, y[ni]);
          }
        }
      }
#pragma unroll
      for (int j = 0; j < 4; ++j) {
        const int l = row0 + quad * 4 + j;
        const long tok = (long)b * S_ + c * 128 + l;
        float sq = 0.f;
#pragma unroll
        for (int ni = 0; ni < 4; ++ni) {
          const int pp = ni * 16 + lr;
          float yv = y[ni][j] + bf2f(Xt[pp * TSTR + l]) * dsk;
          yv *= silu_f(bf2f(proj[tok * DINP_ + C_Z + h * 64 + pp]));
          const u16 yb = f2bf(yv);
          const float yr = bf2f(yb);
          sq += yr * yr;
          mix[tok * 1024 + h * 64 + pp] = yb;
        }
        sq += __shfl_xor(sq, 1); sq += __shfl_xor(sq, 2); sq += __shfl_xor(sq, 4); sq += __shfl_xor(sq, 8);
        if (lr == 0) ssqg[tok * 4 + h] = sq;
      }
    }
  }
#if 0
  const float* gn = INP(p, I_SSMG) + layer * 256;
#pragma unroll 1
  for (int i = 0; i < 16; ++i) {
    int cc = tid + i * 256, l = cc >> 5, c0 = (cc & 31) * 8;
    const float rs = rsqrtf(ssq[l] * (1.f / 256.f) + EPS_);
    u64* ptr = (u64*)(mix + ((long)b * S_ + c * 128 + l) * 1024 + c0);
    U8 x;
    x.d[0] = __hip_atomic_load(ptr, __ATOMIC_RELAXED, __HIP_MEMORY_SCOPE_AGENT);
    x.d[1] = __hip_atomic_load(ptr + 1, __ATOMIC_RELAXED, __HIP_MEMORY_SCOPE_AGENT);
    U8 o;
#pragma unroll
    for (int e = 0; e < 8; ++e) o.s[e] = f2bf(bf2f(x.s[e]) * rs * gn[c0 + e]);
    *(u32x4*)ptr = o.u;
  }
#endif
}

__device__ __forceinline__ void ret_out_item(const Params& p, int layer, int item, char* smem) {
  const int b = item >> 8, c = (item >> 2) & 63, h = item & 3;
  const int tid = TIDX(), lane = tid & 63, wave = tid >> 6, lr = lane & 15, quad = lane >> 4;
  u16* Sc = (u16*)smem;
  u16* Kr = Sc;
  u16* Vt = Sc + 128 * TSTR;
  const u16* proj = PROJ(p);
  const float lg = ret_loggamma(h);
  bf16x8 qf[2][2];
#pragma unroll
  for (int mi = 0; mi < 2; ++mi)
#pragma unroll
    for (int ks = 0; ks < 2; ++ks) {
      float o[8];
      ret_rope8(p, proj, C_RQ + h * 64, b, c * 128 + wave * 32 + mi * 16 + lr, ks * 32 + quad * 8, 1.f, o);
      U8 u;
#pragma unroll
      for (int e = 0; e < 4; ++e) u.w[e] = pack2(o[2 * e], o[2 * e + 1]);
      qf[mi][ks] = u.v;
    }
  __syncthreads();
#pragma unroll 2
  for (int i = 0; i < 4; ++i) {
    int cc = tid + i * 256, l = cc >> 3, d0 = (cc & 7) * 8;
    float o[8];
    ret_rope8(p, proj, C_RK + h * 64, b, c * 128 + l, d0, 0.125f, o);
    U8 u;
#pragma unroll
    for (int e = 0; e < 4; ++e) u.w[e] = pack2(o[2 * e], o[2 * e + 1]);
    *(u32x4*)(Kr + l * 72 + d0) = u.u;
  }
#pragma unroll 2
  for (int i = 0; i < 4; ++i) {
    int cc = tid + i * 256, l = cc >> 3, v0 = (cc & 7) * 8;
    U8 x; x.u = *(const u32x4*)(proj + (long)(b * S_ + c * 128 + l) * DINP_ + C_RV + h * 64 + v0);
#pragma unroll
    for (int e = 0; e < 8; ++e) Vt[(v0 + e) * TSTR + l] = x.s[e];
  }
  __syncthreads();
  f32x4 gacc[2][8];
#pragma unroll
  for (int ni = 0; ni < 8; ++ni) { gacc[0][ni] = (f32x4){0.f, 0.f, 0.f, 0.f}; gacc[1][ni] = (f32x4){0.f, 0.f, 0.f, 0.f}; }
#pragma unroll
  for (int ni = 0; ni < 8; ++ni) {
    if (ni < 2 * (wave + 1)) {
#pragma unroll
      for (int ks = 0; ks < 2; ++ks) {
        bf16x8 bb = *(const bf16x8*)(Kr + (ni * 16 + lr) * 72 + ks * 32 + quad * 8);
        gacc[0][ni] = MFMA(qf[0][ks], bb, gacc[0][ni]);
        gacc[1][ni] = MFMA(qf[1][ks], bb, gacc[1][ni]);
      }
    }
  }
  __syncthreads();
#pragma unroll
  for (int ni = 0; ni < 8; ++ni) {
    if (ni < 2 * (wave + 1)) {
      const int s = ni * 16 + lr;
#pragma unroll
      for (int mi = 0; mi < 2; ++mi)
#pragma unroll
        for (int j = 0; j < 4; ++j) {
          const int l = wave * 32 + mi * 16 + quad * 4 + j;
          float v = (s <= l) ? gacc[mi][ni][j] * __expf((float)(l - s) * lg) : 0.f;
          Sc[l * TSTR + s] = f2bf(v);
        }
    }
  }
  __syncthreads();
  f32x4 y[2][4];
#pragma unroll
  for (int mi = 0; mi < 2; ++mi)
#pragma unroll
    for (int ni = 0; ni < 4; ++ni) y[mi][ni] = (f32x4){0.f, 0.f, 0.f, 0.f};
  const float* prev = (const float*)(WSP(p) + OFF_R + R_RETST) + (long)((b * 64 + c) * 4 + h) * 4096;
#pragma unroll
  for (int ks = 0; ks < 2; ++ks)
#pragma unroll
    for (int ni = 0; ni < 4; ++ni) {
      const float4* pp = (const float4*)(prev + (ni * 16 + lr) * 64 + ks * 32 + quad * 8);
      float4 f0 = pp[0], f1 = pp[1];
      U8 u;
      u.w[0] = pack2(f0.x, f0.y); u.w[1] = pack2(f0.z, f0.w); u.w[2] = pack2(f1.x, f1.y); u.w[3] = pack2(f1.z, f1.w);
      y[0][ni] = MFMA(qf[0][ks], u.v, y[0][ni]);
      y[1][ni] = MFMA(qf[1][ks], u.v, y[1][ni]);
    }
#pragma unroll
  for (int mi = 0; mi < 2; ++mi)
#pragma unroll
    for (int j = 0; j < 4; ++j) {
      const float e = __expf((float)(wave * 32 + mi * 16 + quad * 4 + j + 1) * lg);
#pragma unroll
      for (int ni = 0; ni < 4; ++ni) y[mi][ni][j] *= e;
    }
#pragma unroll
  for (int ks = 0; ks < 4; ++ks) {
    if (ks < wave + 1) {
      bf16x8 a0 = *(const bf16x8*)(Sc + (wave * 32 + lr) * TSTR + ks * 32 + quad * 8);
      bf16x8 a1 = *(const bf16x8*)(Sc + (wave * 32 + 16 + lr) * TSTR + ks * 32 + quad * 8);
#pragma unroll
      for (int ni = 0; ni < 4; ++ni) {
        bf16x8 bb = *(const bf16x8*)(Vt + (ni * 16 + lr) * TSTR + ks * 32 + quad * 8);
        y[0][ni] = MFMA(a0, bb, y[0][ni]);
        y[1][ni] = MFMA(a1, bb, y[1][ni]);
      }
    }
  }
  u16* mix = (u16*)(WSP(p) + OFF_HBF);
#pragma unroll
  for (int mi = 0; mi < 2; ++mi)
#pragma unroll
    for (int j = 0; j < 4; ++j) {
      const int l = wave * 32 + mi * 16 + quad * 4 + j;
      const long tok = (long)b * S_ + c * 128 + l;
      float sq = 0.f;
#pragma unroll
      for (int ni = 0; ni < 4; ++ni) sq += y[mi][ni][j] * y[mi][ni][j];
      sq += __shfl_xor(sq, 1); sq += __shfl_xor(sq, 2); sq += __shfl_xor(sq, 4); sq += __shfl_xor(sq, 8);
      const float rs = rsqrtf(sq * (1.f / 64.f) + EPS_);
#pragma unroll
      for (int ni = 0; ni < 4; ++ni) {
        const int v = ni * 16 + lr;
        const float gt = silu_f(bf2f(proj[tok * DINP_ + C_RG + h * 64 + v]));
        mix[tok * 1024 + 512 + h * 64 + v] = f2bf(y[mi][ni][j] * rs * gt);
      }
    }
}

__device__ __forceinline__ void nsa_item(const Params& p, int item, char* smem) {
  const int b = item >> 8, t0 = (item & 255) * 32;
  const int tid = TIDX(), lane = tid & 63, wave = tid >> 6, lr = lane & 15, quad = lane >> 4;
  u16* Ks = (u16*)smem;
  u16* Vs = Ks + 64 * 72;
  float* imp = (float*)(smem + 18432);
  u64* selm = (u64*)(smem + 18432 + 16384);
  const u16* proj = PROJ(p);
  const int hq = lr & 3;
  const float slope = exp2f(-2.f * (float)(hq + 1)) * 1.4426950408889634f;
  const float c8 = 0.125f * 1.4426950408889634f;
  int tq[2];
  bf16x8 qf[2][2];
  float gt[2][3];
#pragma unroll
  for (int qt = 0; qt < 2; ++qt) {
    tq[qt] = t0 + wave * 8 + qt * 4 + (lr >> 2);
    const u16* row = proj + (long)(b * S_ + tq[qt]) * DINP_;
#pragma unroll
    for (int ks = 0; ks < 2; ++ks) {
      U8 x; x.u = *(const u32x4*)(row + C_NQ + hq * 64 + ks * 32 + quad * 8);
#pragma unroll
      for (int e = 0; e < 4; ++e) x.w[e] = pack2(bf2f(x.s[2 * e]) * c8, bf2f(x.s[2 * e + 1]) * c8);
      qf[ks][qt] = x.v;
    }
#pragma unroll
    for (int j = 0; j < 3; ++j) gt[qt][j] = sigm_f(bf2f(row[C_GATE + hq * 3 + j]));
  }
  f32x4* finl = (f32x4*)(smem + 18432 + 16384 + 512);
  __syncthreads();
  for (int i = tid; i < 4096; i += 256) imp[i] = 0.f;

  auto kf = [=](int kt, int ks) { return *(const bf16x8*)(Ks + (kt * 16 + lr) * 72 + ks * 32 + quad * 8); };
  auto vf = [=](int dt, int kk) {
    U8 u;
    u.d[0] = *(const u64*)(Vs + (dt * 16 + lr) * 72 + kk * 32 + quad * 4);
    u.d[1] = *(const u64*)(Vs + (dt * 16 + lr) * 72 + kk * 32 + 16 + quad * 4);
    return u.v;
  };
  auto kdst = [=](int c) { return (c >> 3) * 72 + (c & 7) * 8; };
  f32x4 o[4][2];
  float m[2], l[2];
  auto reset = [&]() {
#pragma unroll
    for (int dt = 0; dt < 4; ++dt) { o[dt][0] = (f32x4){0.f, 0.f, 0.f, 0.f}; o[dt][1] = (f32x4){0.f, 0.f, 0.f, 0.f}; }
    m[0] = m[1] = -1e30f; l[0] = l[1] = 0.f;
  };
  auto accum = [&](int gi) {
#pragma unroll
    for (int qt = 0; qt < 2; ++qt) {
      float lt = l[qt];
      lt += __shfl_xor(lt, 16);
      lt += __shfl_xor(lt, 32);
      const float sc = lt > 0.f ? gt[qt][gi] / lt : 0.f;
#pragma unroll
      for (int dt = 0; dt < 4; ++dt) {
        f32x4* fp = finl + ((wave * 32 + qt * 16 + lr) * 16 + dt * 4 + quad);
        if (gi == 0) *fp = o[dt][qt] * sc; else *fp = *fp + o[dt][qt] * sc;
      }
    }
  };

  const u16* kc = (const u16*)(WSP(p) + OFF_R + R_KCMP) + (long)b * 512 * 64;
  const u16* vct = (const u16*)(WSP(p) + OFF_R + R_VCT) + (long)b * 64 * 512;
  const int nvmax = t0 / 16 + 1;
  const int ntc = (nvmax + 63) >> 6;
  auto kcs = [=](int t, int c) { return kc + (long)(t * 64 + (c >> 3)) * 64 + (c & 7) * 8; };
  auto vcs = [=](int t, int c) { return vct + (long)(c >> 3) * 512 + t * 64 + (c & 7) * 8; };
  reset();
  const float slope16 = 16.f * slope;
  const int tw0 = t0 + wave * 8;
  const int jlw = tw0 >= 31 ? ((tw0 - 31) >> 4) : -1;
  flash_loop<2>(0, ntc, kcs, kdst, vcs, Ks, Vs, [&](int t) {
    const int jb = t * 64 + quad * 4;
    const int cl0 = (tq[0] >= 31 ? ((tq[0] - 31) >> 4) : -1) - jb, cl1 = (tq[1] >= 31 ? ((tq[1] - 31) >> 4) : -1) - jb;
    const float cf0 = -slope * ((float)(tq[0] - 16 * jb) - 15.5f), cf1 = -slope * ((float)(tq[1] - 16 * jb) - 15.5f);
    const float of0 = cf0 + ft_shift(m[0]), of1 = cf1 + ft_shift(m[1]);
    if (t * 64 + 63 > jlw) flash_tile2<2, false>(kf, vf, AlibiInit<true>{slope16, of0, of1, cl0, cl1, 1 << 20}, NoHook(), qf, o, m, l);
    else flash_tile2<2, false>(kf, vf, AlibiInit<false>{slope16, of0, of1, cl0, cl1, 1 << 20}, NoHook(), qf, o, m, l);
  });
  float invl[2];
#pragma unroll
  for (int qt = 0; qt < 2; ++qt) {
    float lt = l[qt];
    lt += __shfl_xor(lt, 16);
    lt += __shfl_xor(lt, 32);
    invl[qt] = lt > 0.f ? 1.f / lt : 0.f;
    l[qt] = 0.f;
  }
  flash_loop<2>(0, ntc, kcs, kdst, vcs, Ks, Vs, [&](int t) {
    const int jb = t * 64 + quad * 4;
    const int cl0 = (tq[0] >= 31 ? ((tq[0] - 31) >> 4) : -1) - jb, cl1 = (tq[1] >= 31 ? ((tq[1] - 31) >> 4) : -1) - jb;
    const float cf0 = -slope * ((float)(tq[0] - 16 * jb) - 15.5f), cf1 = -slope * ((float)(tq[1] - 16 * jb) - 15.5f);
    const float of0 = cf0 + ft_shift(m[0]), of1 = cf1 + ft_shift(m[1]);
    auto hook = [=](int qt, float (&pv)[4][4]) {
#pragma unroll
      for (int kt = 0; kt < 4; ++kt) {
        float v3 = pv[kt][3] * invl[qt];
        float vs = (pv[kt][0] + pv[kt][1] + pv[kt][2]) * invl[qt] + v3;
        vs += dpp_xor1(vs); vs += dpp_xor2(vs);
        v3 += dpp_xor1(v3); v3 += dpp_xor2(v3);
        if (hq == 0) {
          const int blk = t * 16 + kt * 4 + quad;
          float* ip = imp + (wave * 8 + qt * 4 + (lr >> 2)) * 128;
          atomicAdd(ip + blk, vs);
          if (blk + 1 < 128) atomicAdd(ip + blk + 1, v3);
        }
      }
    };
    if (t * 64 + 63 > jlw) flash_tile2<2, true>(kf, vf, AlibiInit<true>{slope16, of0, of1, cl0, cl1, 1 << 20}, hook, qf, o, m, l);
    else flash_tile2<2, true>(kf, vf, AlibiInit<false>{slope16, of0, of1, cl0, cl1, 1 << 20}, hook, qf, o, m, l);
  });
  accum(0);
  __syncthreads();

  unsigned* usel = (unsigned*)(smem + 18432 + 16384 + 512 + 32768);
  if (tid < 4) usel[tid] = 0u;
  unsigned ulo0 = 0, ulo1 = 0, uhi0 = 0, uhi1 = 0;
#pragma unroll 1
  for (int qi = 0; qi < 8; ++qi) {
    const int t = t0 + wave * 8 + qi, qblk = t >> 6;
    float* ip = imp + (wave * 8 + qi) * 128;
    unsigned k0, k1;
    {
      const int b0 = lane, b1 = lane + 64;
      const unsigned u0 = __float_as_uint(ip[lane]) & 0xFFFFFF80u, u1 = __float_as_uint(ip[64 + lane]) & 0xFFFFFF80u;
      k0 = (b0 > qblk) ? 0u : ((b0 == 0 || b0 == qblk || b0 == qblk - 1) ? 0xFFFFFF80u : u0);
      k1 = (b1 > qblk) ? 0u : ((b1 == qblk || b1 == qblk - 1) ? 0xFFFFFF80u : u1);
      k0 |= (unsigned)(127 - b0);
      k1 |= (unsigned)(127 - b1);
    }
    unsigned* kp = (unsigned*)ip;
    kp[lane] = k0; kp[64 + lane] = k1;
    asm volatile("s_waitcnt lgkmcnt(0)" ::: "memory");
    int r0 = 0, r1 = 0;
#pragma unroll 8
    for (int j4 = 0; j4 < 32; ++j4) {
      const u32x4 w = *(const u32x4*)(kp + j4 * 4);
#pragma unroll
      for (int e = 0; e < 4; ++e) {
        r0 += (w[e] > k0) ? 1 : 0;
        r1 += (w[e] > k1) ? 1 : 0;
      }
    }
    u64 mlo = __ballot(r0 < 16 && lane <= qblk);
    u64 mhi = __ballot(r1 < 16 && lane + 64 <= qblk);
    if (lane == 0) { selm[(wave * 8 + qi) * 2] = mlo; selm[(wave * 8 + qi) * 2 + 1] = mhi; }
    ulo0 |= (unsigned)mlo; ulo1 |= (unsigned)(mlo >> 32); uhi0 |= (unsigned)mhi; uhi1 |= (unsigned)(mhi >> 32);
  }
  __syncthreads();
  if (lane == 0) { atomicOr(usel + 0, ulo0); atomicOr(usel + 1, ulo1); atomicOr(usel + 2, uhi0); atomicOr(usel + 3, uhi1); }
  __syncthreads();
  u64 sm_lo[2], sm_hi[2];
#pragma unroll
  for (int qt = 0; qt < 2; ++qt) {
    sm_lo[qt] = selm[(wave * 8 + qt * 4 + (lr >> 2)) * 2];
    sm_hi[qt] = selm[(wave * 8 + qt * 4 + (lr >> 2)) * 2 + 1];
  }
  reset();
  {
    const u16* ksb = proj + (long)b * S_ * DINP_ + C_NKS;
    const u16* vst = (const u16*)(WSP(p) + OFF_VST) + (long)b * 64 * 8192;
    LAS int* blist = (LAS int*)imp;
    int nun = 0;
    {
      const unsigned u0 = usel[0], u1 = usel[1], u2 = usel[2], u3 = usel[3];
      __syncthreads();
      if (tid < 128) {
        const unsigned wd = tid < 32 ? u0 : tid < 64 ? u1 : tid < 96 ? u2 : u3;
        const int bit = tid & 31;
        if ((wd >> bit) & 1u) {
          int pos = __popc(wd & ((1u << bit) - 1u));
          if (tid >= 32) pos += __popc(u0);
          if (tid >= 64) pos += __popc(u1);
          if (tid >= 96) pos += __popc(u2);
          blist[pos] = tid;
        }
      }
      nun = __popc(u0) + __popc(u1) + __popc(u2) + __popc(u3);
      __syncthreads();
    }
    const unsigned w0m = __builtin_amdgcn_readfirstlane(ulo0), w1m = __builtin_amdgcn_readfirstlane(ulo1),
                   w2m = __builtin_amdgcn_readfirstlane(uhi0), w3m = __builtin_amdgcn_readfirstlane(uhi1);
    flash_loop<2>(0, nun,
        [=](int blk, int c) { return ksb + (long)(blk * 64 + (c >> 3)) * DINP_ + (c & 7) * 8; }, kdst,
        [=](int blk, int c) { return vst + (long)(c >> 3) * 8192 + blk * 64 + (c & 7) * 8; }, Ks, Vs,
        [&](int blk) {
          const unsigned wm = blk < 32 ? w0m : blk < 64 ? w1m : blk < 96 ? w2m : w3m;
          if ((wm >> (blk & 31)) & 1u) {
            const int k0 = blk * 64;
            const bool s0 = ((blk < 64 ? sm_lo[0] : sm_hi[0]) >> (blk & 63)) & 1ull;
            const bool s1 = ((blk < 64 ? sm_lo[1] : sm_hi[1]) >> (blk & 63)) & 1ull;
            const int l0 = tq[0] - k0 - quad * 4, l1 = tq[1] - k0 - quad * 4;
            const float f0 = s0 ? -slope * (float)l0 + ft_shift(m[0]) : -INFINITY, f1 = s1 ? -slope * (float)l1 + ft_shift(m[1]) : -INFINITY;
            if (k0 + 63 > tw0) flash_tile2<2, true>(kf, vf, AlibiInit<true>{slope, f0, f1, l0, l1, 1 << 20}, NoHook(), qf, o, m, l);
            else flash_tile2<2, true>(kf, vf, AlibiInit<false>{slope, f0, f1, l0, l1, 1 << 20}, NoHook(), qf, o, m, l);
          }
        }, [=](int t) { return (int)blist[t]; });
  }
  accum(1);
  reset();
  {
    const u16* kwb = proj + (long)b * S_ * DINP_ + C_NKW;
    const u16* vwt = (const u16*)(WSP(p) + OFF_VWT) + (long)b * 64 * 8192;
    const int w0 = (t0 >= 511 ? t0 - 511 : 0) >> 6, w1 = ((t0 + 31) >> 6) + 1;
    flash_loop<2>(w0, w1,
        [=](int t, int c) { return kwb + (long)(t * 64 + (c >> 3)) * DINP_ + (c & 7) * 8; }, kdst,
        [=](int t, int c) { return vwt + (long)(c >> 3) * 8192 + t * 64 + (c & 7) * 8; }, Ks, Vs,
        [&](int t) {
          const int l0 = tq[0] - t * 64 - quad * 4, l1 = tq[1] - t * 64 - quad * 4;
          const float f0 = -slope * (float)l0 + ft_shift(m[0]), f1 = -slope * (float)l1 + ft_shift(m[1]);
          if (t * 64 + 63 > tw0 || t * 64 <= tw0 + 7 - 512) flash_tile2<2, true>(kf, vf, AlibiInit<true>{slope, f0, f1, l0, l1, 512}, NoHook(), qf, o, m, l);
          else flash_tile2<2, true>(kf, vf, AlibiInit<false>{slope, f0, f1, l0, l1, 512}, NoHook(), qf, o, m, l);
        });
  }
  accum(2);
  u16* mix = (u16*)(WSP(p) + OFF_HBF);
#pragma unroll
  for (int qt = 0; qt < 2; ++qt) {
    u16* orow = mix + (long)(b * S_ + tq[qt]) * 1024 + 768 + hq * 64;
#pragma unroll
    for (int dt = 0; dt < 4; ++dt) {
      const f32x4 fv = finl[(wave * 32 + qt * 16 + lr) * 16 + dt * 4 + quad];
      u32x2 pk;
      pk.x = pack2(fv[0], fv[1]);
      pk.y = pack2(fv[2], fv[3]);
      *(u32x2*)(orow + dt * 16 + quad * 4) = pk;
    }
  }
}

__device__ __forceinline__ void phase4(const Params& p, int layer, char* smem) {
  int* cnt = (int*)(WSP(p) + OFF_CNT) + layer * 16;
  QLOOP(13, 384, mla_combine_item(p, it))
  QLOOP(10, 512, ssd_out_item(p, layer, it, smem))
  QLOOP_X(40, 64, nsa_item(p, qx * 64 + 63 - qd, smem))
  QLOOP(12, 512, ret_out_item(p, layer, it, smem))
}


#define XB_TMO      128
#define XB_XCNT(j)  (256  + 64 * (j))
#define XB_XSUB(j)  (1280 + 64 * (j))
#define XB_XGEN(j)  (2304 + 64 * (j))
#define XB_TOP      3328
#define XB_TOPGEN   3392
#define XCD_BAR_WORDS 3456
#define XB_SPIN_CAP (1u << 20)
__device__ __forceinline__ unsigned xb_ld(unsigned* p) { return __hip_atomic_load(p, __ATOMIC_RELAXED, __HIP_MEMORY_SCOPE_AGENT); }
__device__ __forceinline__ unsigned xb_add(unsigned* p, unsigned v) { return __hip_atomic_fetch_add(p, v, __ATOMIC_RELAXED, __HIP_MEMORY_SCOPE_AGENT); }
__device__ __forceinline__ unsigned xb_xcc_id() { return (unsigned)__builtin_amdgcn_s_getreg((3 << 11) | 20) & 0xFu; }
#define XB_SPIN(cond, bar) do { unsigned _sp = 0; while (cond) { __builtin_amdgcn_s_sleep(1); \
    if ((++_sp & 255u) == 0u) { if (xb_ld(&(bar)[XB_TMO])) break; if (_sp > XB_SPIN_CAP) { atomicAdd(&(bar)[XB_TMO], 1u); break; } } } } while (0)
struct XcdBarrier { unsigned* bar; unsigned x; volatile LAS unsigned* st; };
__device__ __forceinline__ XcdBarrier xcd_barrier_post(unsigned* bar, volatile LAS unsigned* st) {
  XcdBarrier b; b.bar = bar; b.x = xb_xcc_id(); b.st = st;
  if (__builtin_amdgcn_workitem_id_x() == 0) (void)xb_add(&bar[XB_XCNT(b.x)], 1u);
  return b;
}
__device__ __forceinline__ void xcd_barrier_complete(unsigned* bar, unsigned x, unsigned& nloc, unsigned& nx) {
  const unsigned G = gridDim.x * gridDim.y * gridDim.z;
  unsigned sum, cnt, mine, sp = 0u;
  for (;;) {
    sum = 0u; cnt = 0u; mine = 0u;
#pragma unroll
    for (unsigned j = 0; j < 16; ++j) { const unsigned c = xb_ld(&bar[XB_XCNT(j)]); sum += c; cnt += (c > 0u) ? 1u : 0u; mine = (j == x) ? c : mine; }
    if (sum == G) break;
    __builtin_amdgcn_s_sleep(1);
    if ((++sp & 255u) == 0u) { if (xb_ld(&bar[XB_TMO])) break; if (sp > XB_SPIN_CAP) { atomicAdd(&bar[XB_TMO], 1u); break; } }
  }
  nloc = mine > 0u ? mine : 1u; nx = cnt > 0u ? cnt : 1u;
}
__device__ __forceinline__ void xcd_barrier(const XcdBarrier& b) {
  asm volatile("s_waitcnt vmcnt(0)" ::: "memory");
  __syncthreads();
  if (__builtin_amdgcn_workitem_id_x() == 0) {
    unsigned* bar = b.bar;
    __builtin_amdgcn_s_waitcnt(0);
    unsigned nloc = b.st[0], nx = b.st[1];
    if (nloc == 0u) { xcd_barrier_complete(bar, b.x, nloc, nx); b.st[0] = nloc; b.st[1] = nx; }
    const unsigned old = xb_add(&bar[XB_XSUB(b.x)], 1u);
    const unsigned gen = old / nloc;
    if (old + 1u == (gen + 1u) * nloc) {
      __builtin_amdgcn_fence(__ATOMIC_RELEASE, "agent");
      asm volatile("s_waitcnt vmcnt(0)" ::: "memory");
      const unsigned og = xb_add(&bar[XB_TOP], 1u);
      const unsigned tg = og / nx;
      if (og + 1u == (tg + 1u) * nx) xb_add(&bar[XB_TOPGEN], 1u);
      else XB_SPIN(xb_ld(&bar[XB_TOPGEN]) == tg, bar);
      __builtin_amdgcn_fence(__ATOMIC_ACQUIRE, "agent");
      xb_add(&bar[XB_XGEN(b.x)], 1u);
      asm volatile("s_waitcnt vmcnt(0)" ::: "memory");
    } else {
      XB_SPIN(xb_ld(&bar[XB_XGEN(b.x)]) == gen, bar);
      __builtin_amdgcn_fence(__ATOMIC_ACQUIRE, "agent");
      asm volatile("s_waitcnt vmcnt(0)" ::: "memory");
    }
  }
  __syncthreads();
}

constexpr int NPHASE = 1 + 9 * 2;
template <int KIND>
__device__ __forceinline__ void run_kind(const Params& p, int layer, int bid, int nb, char* smem) {
  if (KIND == 9) phase0(p, bid, nb, smem);
  if (KIND == 0) phase_inproj(p, bid, nb, smem);
  if (KIND == 1) phase2(p, layer, smem);
  if (KIND == 2) phase3(p, layer, smem);
  if (KIND == 3) phase4(p, layer, smem);
  if (KIND == 4) phase_resgemm<true>(p, bid, nb, smem, (const u16*)(WSP(p) + OFF_HBF), 1024, (const u16*)(WSP(p) + OFF_WT_OUT),
                                     layer == 0 ? nullptr : (const float*)(WSP(p) + OFF_LNST) + (long)T_ * 2, INP(p, I_LN2G), INP(p, I_LN2B));
  if (KIND == 5) phase_ln(p, bid, nb, smem, INP(p, I_LN1G) + layer * 1024, INP(p, I_LN1B) + layer * 1024, -1, 0, false);
  if (KIND == 6) phase_mlp1(p, bid, nb, smem);
  if (KIND == 7) phase_resgemm<false>(p, bid, nb, smem, (const u16*)(WSP(p) + OFF_R), 4096, (const u16*)(WSP(p) + OFF_WT_M2),
                                      (const float*)(WSP(p) + OFF_LNST), INP(p, I_LN1G) + layer * 1024, INP(p, I_LN1B) + layer * 1024);
  if (KIND == 8) phase_ln(p, bid, nb, smem, INP(p, I_LN2G) + layer * 1024, INP(p, I_LN2B) + layer * 1024, layer == 0 ? 1 : -1, 1, layer == 1);
}

#if MEGA
__global__ void __launch_bounds__(256, 2) mega_kernel(Params p) {
  __shared__ __attribute__((aligned(16))) char smem[SMEM_BYTES];
  cg::grid_group grid = cg::this_grid();
  const int bid = blockIdx.x, nb = gridDim.x;
  volatile LAS unsigned* st = (volatile LAS unsigned*)(smem + SMEM_BYTES - 32);
  if (__builtin_amdgcn_workitem_id_x() == 0) { st[0] = 0u; st[1] = 0u; }
  __syncthreads();
  if (bid == 0) { unsigned* bw = (unsigned*)(p.ws + OFF_BAR); for (int i = __builtin_amdgcn_workitem_id_x(); i < XCD_BAR_WORDS; i += 256) bw[i] = 0u; }
  run_kind<9>(p, 0, bid, nb, smem);
  grid.sync();
  XcdBarrier xb = xcd_barrier_post((unsigned*)(p.ws + OFF_BAR), st);
#pragma unroll 1
  for (int layer = 0; layer < 2; ++layer) {
    run_kind<0>(p, layer, bid, nb, smem); xcd_barrier(xb);
    run_kind<1>(p, layer, bid, nb, smem); xcd_barrier(xb);
    run_kind<2>(p, layer, bid, nb, smem); xcd_barrier(xb);
    run_kind<3>(p, layer, bid, nb, smem); xcd_barrier(xb);
    run_kind<4>(p, layer, bid, nb, smem); xcd_barrier(xb);
    run_kind<5>(p, layer, bid, nb, smem); xcd_barrier(xb);
    run_kind<6>(p, layer, bid, nb, smem); xcd_barrier(xb);
    run_kind<7>(p, layer, bid, nb, smem); xcd_barrier(xb);
    run_kind<8>(p, layer, bid, nb, smem);
    if (layer == 0) xcd_barrier(xb);
  }
}
#else
template <int KIND>
__global__ void __launch_bounds__(256, 2) phase_kernel(Params p, int layer) {
  __shared__ __attribute__((aligned(16))) char smem[SMEM_BYTES];
  run_kind<KIND>(p, layer, blockIdx.x, gridDim.x, smem);
}
#endif

extern "C" void kernel_launch(void* const* d_in, const int* in_sizes, int n_in, void* d_out, int out_size, void* d_ws,
                              size_t ws_size, hipStream_t stream) {
  if (n_in != 27 || ws_size < WS_TOTAL) { fprintf(stderr, "kernel_launch: bad inputs n_in=%d ws=%zu need %zu\n", n_in, ws_size, (size_t)WS_TOTAL); return; }
  Params p{};
  for (int i = 0; i < 27; ++i) p.in[i] = (const float*)d_in[i];
  p.h32 = (float*)d_out;
  p.ws = (char*)d_ws;
#if MEGA
  static int grid_blocks = 0;
  if (!grid_blocks) {
    int dev = 0, cus = 0, per_cu = 0;
    hipGetDevice(&dev);
    hipDeviceGetAttribute(&cus, hipDeviceAttributeMultiprocessorCount, dev);
    hipOccupancyMaxActiveBlocksPerMultiprocessor(&per_cu, mega_kernel, 256, 0);
    if (per_cu > 2) per_cu = 2;
    grid_blocks = cus * per_cu;
    fprintf(stderr, "kernel_launch: cus=%d per_cu=%d grid=%d\n", cus, per_cu, grid_blocks);
  }
  void* args[] = {&p};
  hipError_t e = hipLaunchCooperativeKernel((void*)mega_kernel, dim3(grid_blocks), dim3(256), args, 0, stream);
  if (e != hipSuccess) fprintf(stderr, "cooperative launch failed: %s (grid %d)\n", hipGetErrorString(e), grid_blocks);
#else
  hipLaunchKernelGGL(phase_kernel<9>, dim3(512), dim3(256), 0, stream, p, 0);
  for (int layer = 0; layer < 2; ++layer) {
    hipLaunchKernelGGL(phase_kernel<0>, dim3(512), dim3(256), 0, stream, p, layer);
    hipLaunchKernelGGL(phase_kernel<1>, dim3(512), dim3(256), 0, stream, p, layer);
    hipLaunchKernelGGL(phase_kernel<2>, dim3(512), dim3(256), 0, stream, p, layer);
    hipLaunchKernelGGL(phase_kernel<3>, dim3(512), dim3(256), 0, stream, p, layer);
    hipLaunchKernelGGL(phase_kernel<4>, dim3(512), dim3(256), 0, stream, p, layer);
    hipLaunchKernelGGL(phase_kernel<5>, dim3(512), dim3(256), 0, stream, p, layer);
    hipLaunchKernelGGL(phase_kernel<6>, dim3(512), dim3(256), 0, stream, p, layer);
    hipLaunchKernelGGL(phase_kernel<7>, dim3(512), dim3(256), 0, stream, p, layer);
    hipLaunchKernelGGL(phase_kernel<8>, dim3(512), dim3(256), 0, stream, p, layer);
  }
#endif
}
```

```cpp
#include <hip/hip_runtime.h>
#include <hip/hip_cooperative_groups.h>
#include <cstdio>
namespace cg = cooperative_groups;

#ifndef MEGA
#define MEGA 1
#endif

typedef unsigned short u16;
typedef unsigned long long u64;
typedef __attribute__((ext_vector_type(8))) short bf16x8;
typedef __attribute__((ext_vector_type(4))) float f32x4;
typedef unsigned __attribute__((ext_vector_type(4))) u32x4;
typedef unsigned __attribute__((ext_vector_type(2))) u32x2;
#define LAS __attribute__((address_space(3)))
#define GAS __attribute__((address_space(1)))
#define MFMA(a, b, c) __builtin_amdgcn_mfma_f32_16x16x32_bf16(a, b, c, 0, 0, 0)

constexpr int S_ = 8192, T_ = 16384, DM_ = 1024, DINP_ = 3200, DFF_ = 4096;
constexpr int C_Z = 0, C_XS = 256, C_CQ = 1024, C_CKV = 1280, C_KR = 1408, C_RQ = 1440, C_RK = 1696, C_RV = 1952,
              C_RG = 2208, C_NQ = 2464, C_NKC = 2720, C_NVC = 2784, C_NKS = 2848, C_NVS = 2912, C_NKW = 2976,
              C_NVW = 3040, C_DT = 3104, C_GATE = 3108;
constexpr float EPS_ = 1e-5f;
constexpr float ALPHA_ = 1.41421356237309515f;

constexpr size_t OFF_WT_IN = 0, OFF_WT_OUT = 6553600, OFF_WT_M1 = 8650752, OFF_WT_M2 = 17039360, OFF_WT_UQ = 25427968,
                 OFF_WT_UKV = 25624576, OFF_WT_C1K = 25755648, OFF_WT_C1V = 26804224, OFF_WT_C2K = 27852800,
                 OFF_WT_C2V = 27918336, OFF_BIASP = 27983872, OFF_COSM = 28016640, OFF_SINM = 28540928,
                 OFF_COSR = 29065216, OFF_SINR = 30113792, OFF_CNT = 31162368, OFF_SSDDEC = 31166464,
                 OFF_R = 31170560, OFF_HBF = 165388288, OFF_QMLA = 198942720, OFF_KBUF = 211525632,
                 OFF_VTMLA = 224108544, OFF_VST = 232497152, OFF_VWT = 234594304, OFF_BAR = 236691456, OFF_SSQ = 236691456 + 16384, OFF_MLAP = 236969984, OFF_MLAML = 257941504, OFF_LNST = 259252224, WS_TOTAL = 259252224 + 262144;
constexpr size_t R_PROJ = 0, R_SSDST = 105267200, R_RETST = 122044416, R_HID = 130433024, R_KCMP = 131481600,
                 R_VCT = 131612672;

constexpr int SMEM_BYTES = 75776;
constexpr int GSTR = 72;
constexpr int TSTR = 136;

struct Params {
  const float* in[27];
  float* h32;
  char* ws;
};
enum { I_X = 0, I_LNEG, I_LNEB, I_WIN, I_CONVW, I_CONVB, I_DTB, I_ALOG, I_DSKIP, I_SSMG, I_QNG, I_WUQ, I_KVNG, I_WUKV,
       I_PEK, I_W1K, I_W2K, I_PEV, I_W1V, I_W2V, I_WOUT, I_LN1G, I_LN1B, I_WM1, I_WM2, I_LN2G, I_LN2B };


__device__ __forceinline__ int TIDX() { int t = __builtin_amdgcn_workitem_id_x(); asm volatile("" : "+v"(t)); return t; }

__device__ __forceinline__ char* WSP(const Params& p) { GAS char* w = (GAS char*)p.ws; asm volatile("" : "+s"(w)); return (char*)w; }
__device__ __forceinline__ const float* INP(const Params& p, int i) { GAS const float* q = (GAS const float*)p.in[i]; asm volatile("" : "+s"(q)); return (const float*)q; }
union U8 { u32x4 u; bf16x8 v; u16 s[8]; unsigned w[4]; u64 d[2]; };

__device__ __forceinline__ float bf2f(u16 v) { return __uint_as_float(((unsigned)v) << 16); }
typedef __bf16 bf16v2_t __attribute__((ext_vector_type(2)));
typedef float floatv2_t __attribute__((ext_vector_type(2)));
__device__ __forceinline__ u16 f2bf(float f) { return __builtin_bit_cast(u16, (__bf16)f); }
__device__ __forceinline__ unsigned pack2(float a, float b) { floatv2_t f = {a, b}; return __builtin_bit_cast(unsigned, __builtin_convertvector(f, bf16v2_t)); }
__device__ __forceinline__ float silu_f(float x) { return x * __builtin_amdgcn_rcpf(1.f + __expf(-x)); }
__device__ __forceinline__ float sigm_f(float x) { return __builtin_amdgcn_rcpf(1.f + __expf(-x)); }
__device__ __forceinline__ float dpp_xor1(float v) { return __int_as_float(__builtin_amdgcn_mov_dpp(__float_as_int(v), 0xB1, 0xF, 0xF, true)); }
__device__ __forceinline__ float dpp_xor2(float v) { return __int_as_float(__builtin_amdgcn_mov_dpp(__float_as_int(v), 0x4E, 0xF, 0xF, true)); }
__device__ __forceinline__ float wave_sum(float v) {
#pragma unroll
  for (int o = 32; o > 0; o >>= 1) v += __shfl_xor(v, o);
  return v;
}
__device__ __forceinline__ const u16* PROJ(const Params& p) { return (const u16*)(WSP(p) + OFF_R + R_PROJ); }

__device__ __forceinline__ int next_item(int* counter, char* smem) {
  int* sh = (int*)(smem + SMEM_BYTES - 16);
  __syncthreads();
  if (TIDX() == 0) *sh = atomicAdd(counter, 1);
  __syncthreads();
  return *sh;
}

struct NoMid { __device__ __forceinline__ void operator()(int, f32x4 (&)[4][4]) const {} };
template <bool SWAP, class ARow, class Epi, class Mid = NoMid>
__device__ __forceinline__ void gemm_tile(ARow arow, const int a_kstride, const u16* __restrict__ Bt, const int ldb,
                                          const int K, const int n0, Epi epi, u16* smem, Mid mid = NoMid()) {
  const int tid = TIDX(), lane = tid & 63, wave = tid >> 6;
  const int wm = wave >> 1, wn = wave & 1, lr = lane & 15, quad = lane >> 4;
  const int srow = tid >> 3, sch = tid & 7;
  const u16* ap[4];
  const u16* bp[4];
#pragma unroll
  for (int i = 0; i < 4; ++i) {
    const int r = srow + i * 32;
    const int gch = sch ^ ((r >> 1) & 7);
    ap[i] = arow(r) + gch * 8;
    bp[i] = Bt + (long)(n0 + r) * ldb + gch * 8;
  }
  f32x4 acc[4][4];
#pragma unroll
  for (int i = 0; i < 4; ++i)
#pragma unroll
    for (int j = 0; j < 4; ++j) acc[i][j] = (f32x4){0.f, 0.f, 0.f, 0.f};
  const int nkt = K >> 6;
#define GEMM_STAGE(KT, BUF)                                                                                   \
  {                                                                                                            \
    u16* ab_ = smem + (BUF) * 16384;                                                                           \
    _Pragma("unroll") for (int i = 0; i < 4; ++i) {                                                            \
      __builtin_amdgcn_global_load_lds((GAS const unsigned*)(ap[i] + (long)(KT) * a_kstride),                  \
                                       (LAS unsigned*)(ab_ + (srow + i * 32) * 64 + sch * 8), 16, 0, 0);       \
      __builtin_amdgcn_global_load_lds((GAS const unsigned*)(bp[i] + (KT) * 64),                               \
                                       (LAS unsigned*)(ab_ + 8192 + (srow + i * 32) * 64 + sch * 8), 16, 0, 0); \
    }                                                                                                          \
  }
  __syncthreads();
  GEMM_STAGE(0, 0)
  int aoff[4], boff[4];
#pragma unroll
  for (int mi = 0; mi < 4; ++mi) { const int r = wm * 64 + mi * 16 + lr; aoff[mi] = r * 64; }
#pragma unroll
  for (int ni = 0; ni < 4; ++ni) { const int r = wn * 64 + ni * 16 + lr; boff[ni] = 8192 + r * 64; }
  const int swz = (lr >> 1) & 7;
#pragma unroll 1
  for (int kt = 0; kt < nkt; ++kt) {
    asm volatile("s_waitcnt vmcnt(0)" ::: "memory");
    __syncthreads();
    if (kt + 1 < nkt) GEMM_STAGE(kt + 1, (kt + 1) & 1)
    const u16* buf = smem + (kt & 1) * 16384;
    {
      bf16x8 a[2][4], b[2][4];
#pragma unroll
      for (int ks = 0; ks < 2; ++ks) {
        const int coff = ((ks * 4 + quad) ^ swz) * 8;
#pragma unroll
        for (int mi = 0; mi < 4; ++mi) a[ks][mi] = *(const bf16x8*)(buf + aoff[mi] + coff);
#pragma unroll
        for (int ni = 0; ni < 4; ++ni) b[ks][ni] = *(const bf16x8*)(buf + boff[ni] + coff);
      }
      __builtin_amdgcn_sched_barrier(0);
#pragma unroll
      for (int ks = 0; ks < 2; ++ks)
#pragma unroll
        for (int mi = 0; mi < 4; ++mi)
#pragma unroll
          for (int ni = 0; ni < 4; ++ni)
            acc[mi][ni] = SWAP ? MFMA(b[ks][ni], a[ks][mi], acc[mi][ni]) : MFMA(a[ks][mi], b[ks][ni], acc[mi][ni]);
    }
    mid(kt, acc);
  }
#undef GEMM_STAGE
#pragma unroll
  for (int mi = 0; mi < 4; ++mi) {
#pragma unroll
    for (int ni = 0; ni < 4; ++ni) {
      if (SWAP) epi(wm * 64 + mi * 16 + lr, wn * 64 + ni * 16 + quad * 4, acc[mi][ni]);
      else epi(wm * 64 + mi * 16 + quad * 4, wn * 64 + ni * 16 + lr, acc[mi][ni]);
    }
    asm volatile("" ::: "memory");
  }
}

template <int NKS, bool PV, class KF, class VF, class MB, class PH>
__device__ __forceinline__ void flash_tile(KF kf, VF vf, MB mb, PH ph, const bf16x8 (&qf)[NKS][2], f32x4 (&o)[4][2],
                                           float (&m)[2], float (&l)[2]) {
  const int quad = (TIDX() & 63) >> 4;
  f32x4 s[2][4];
#pragma unroll
  for (int kt = 0; kt < 4; ++kt) {
    s[0][kt] = (f32x4){0.f, 0.f, 0.f, 0.f};
    s[1][kt] = (f32x4){0.f, 0.f, 0.f, 0.f};
#pragma unroll
    for (int ks = 0; ks < NKS; ++ks) {
      bf16x8 a = kf(kt, ks);
      s[0][kt] = MFMA(a, qf[ks][0], s[0][kt]);
      s[1][kt] = MFMA(a, qf[ks][1], s[1][kt]);
    }
  }
  bf16x8 pb[2][2];
#pragma unroll
  for (int qt = 0; qt < 2; ++qt) {
    float mx = -INFINITY;
#pragma unroll
    for (int kt = 0; kt < 4; ++kt)
#pragma unroll
      for (int j = 0; j < 4; ++j) {
        float v = mb(kt * 16 + j, qt, s[qt][kt][j]);
        s[qt][kt][j] = v;
        mx = fmaxf(mx, v);
      }
    mx = fmaxf(mx, __shfl_xor(mx, 16));
    mx = fmaxf(mx, __shfl_xor(mx, 32));
    const float mnew = fmaxf(m[qt], mx);
    const float alpha = __builtin_amdgcn_exp2f(m[qt] - mnew);
    m[qt] = mnew;
    float ps = 0.f;
    float pv[4][4];
#pragma unroll
    for (int kt = 0; kt < 4; ++kt)
#pragma unroll
      for (int j = 0; j < 4; ++j) {
        float e = __builtin_amdgcn_exp2f(s[qt][kt][j] - mnew);
        pv[kt][j] = e;
        ps += e;
      }
    l[qt] = l[qt] * alpha + ps;
    ph(qt, pv);
    if (PV) {
#pragma unroll
      for (int dt = 0; dt < 4; ++dt) o[dt][qt] *= alpha;
#pragma unroll
      for (int kk = 0; kk < 2; ++kk) {
        U8 u;
        u.w[0] = pack2(pv[2 * kk][0], pv[2 * kk][1]);
        u.w[1] = pack2(pv[2 * kk][2], pv[2 * kk][3]);
        u.w[2] = pack2(pv[2 * kk + 1][0], pv[2 * kk + 1][1]);
        u.w[3] = pack2(pv[2 * kk + 1][2], pv[2 * kk + 1][3]);
        pb[qt][kk] = u.v;
      }
    }
  }
  if (PV) {
#pragma unroll
    for (int kk = 0; kk < 2; ++kk)
#pragma unroll
      for (int dt = 0; dt < 4; ++dt) {
        bf16x8 a = vf(dt, kk);
        o[dt][0] = MFMA(a, pb[0][kk], o[dt][0]);
        o[dt][1] = MFMA(a, pb[1][kk], o[dt][1]);
      }
  }
}

constexpr float FT_T = 16.f;
template <int NKS, bool PV, class KF, class VF, class CI, class PH>
__device__ __forceinline__ void flash_tile2(KF kf, VF vf, CI cin, PH ph, const bf16x8 (&qf)[NKS][2], f32x4 (&o)[4][2],
                                            float (&m)[2], float (&l)[2]) {
  f32x4 s[2][4];
  if (NKS == 2) {
    bf16x8 kfr[4][NKS];
#pragma unroll
    for (int kt = 0; kt < 4; ++kt)
#pragma unroll
      for (int ks = 0; ks < NKS; ++ks) kfr[kt][ks] = kf(kt, ks);
    __builtin_amdgcn_sched_barrier(0);
#pragma unroll
    for (int kt = 0; kt < 4; ++kt) {
      s[0][kt] = cin(0, kt);
      s[1][kt] = cin(1, kt);
#pragma unroll
      for (int ks = 0; ks < NKS; ++ks) {
        s[0][kt] = MFMA(kfr[kt][ks], qf[ks][0], s[0][kt]);
        s[1][kt] = MFMA(kfr[kt][ks], qf[ks][1], s[1][kt]);
      }
    }
  } else {
    bf16x8 kfr[2][NKS];
#pragma unroll
    for (int ks = 0; ks < NKS; ++ks) kfr[0][ks] = kf(0, ks);
#pragma unroll
    for (int kt = 0; kt < 4; ++kt) {
      if (kt + 1 < 4) {
#pragma unroll
        for (int ks = 0; ks < NKS; ++ks) kfr[(kt + 1) & 1][ks] = kf(kt + 1, ks);
      }
      __builtin_amdgcn_sched_barrier(0);
      s[0][kt] = cin(0, kt);
      s[1][kt] = cin(1, kt);
#pragma unroll
      for (int ks = 0; ks < NKS; ++ks) {
        s[0][kt] = MFMA(kfr[kt & 1][ks], qf[ks][0], s[0][kt]);
        s[1][kt] = MFMA(kfr[kt & 1][ks], qf[ks][1], s[1][kt]);
      }
    }
  }
  float mx[2];
#pragma unroll
  for (int qt = 0; qt < 2; ++qt) {
    float a = -INFINITY;
#pragma unroll
    for (int kt = 0; kt < 4; ++kt) a = fmaxf(a, fmaxf(fmaxf(s[qt][kt][0], s[qt][kt][1]), fmaxf(s[qt][kt][2], s[qt][kt][3])));
    mx[qt] = a;
  }
  const bool un0 = m[0] < -1e29f, un1 = m[1] < -1e29f;
  const bool need = (un0 ? (mx[0] > -INFINITY) : (mx[0] > FT_T)) || (un1 ? (mx[1] > -INFINITY) : (mx[1] > FT_T));
  if (__any(need)) {
#pragma unroll
    for (int qt = 0; qt < 2; ++qt) {
      float mq = mx[qt];
      mq = fmaxf(mq, __shfl_xor(mq, 16));
      mq = fmaxf(mq, __shfl_xor(mq, 32));
      const bool un = m[qt] < -1e29f;
      float delta = 0.f;
      if (un) {
        if (mq > -INFINITY) { delta = mq; m[qt] = mq; }
      } else if (mq > FT_T) {
        delta = mq;
        m[qt] += mq;
        const float sc = __builtin_amdgcn_exp2f(-mq);
        l[qt] *= sc;
        if (PV) {
#pragma unroll
          for (int dt = 0; dt < 4; ++dt) o[dt][qt] *= sc;
        }
      }
#pragma unroll
      for (int kt = 0; kt < 4; ++kt) s[qt][kt] -= delta;
    }
  }
  bf16x8 pb[2][2];
#pragma unroll
  for (int qt = 0; qt < 2; ++qt) {
    float ps = 0.f;
    float pv[4][4];
#pragma unroll
    for (int kt = 0; kt < 4; ++kt)
#pragma unroll
      for (int j = 0; j < 4; ++j) {
        float e = __builtin_amdgcn_exp2f(s[qt][kt][j]);
        pv[kt][j] = e;
        ps += e;
      }
    l[qt] += ps;
    ph(qt, pv);
    if (PV) {
#pragma unroll
      for (int kk = 0; kk < 2; ++kk) {
        U8 u;
        u.w[0] = pack2(pv[2 * kk][0], pv[2 * kk][1]);
        u.w[1] = pack2(pv[2 * kk][2], pv[2 * kk][3]);
        u.w[2] = pack2(pv[2 * kk + 1][0], pv[2 * kk + 1][1]);
        u.w[3] = pack2(pv[2 * kk + 1][2], pv[2 * kk + 1][3]);
        pb[qt][kk] = u.v;
      }
    }
  }
  if (PV) {
    bf16x8 vfr[2][4];
#pragma unroll
    for (int kk = 0; kk < 2; ++kk)
#pragma unroll
      for (int dt = 0; dt < 4; ++dt) vfr[kk][dt] = vf(dt, kk);
#pragma unroll
    for (int kk = 0; kk < 2; ++kk)
#pragma unroll
      for (int dt = 0; dt < 4; ++dt) {
        o[dt][0] = MFMA(vfr[kk][dt], pb[0][kk], o[dt][0]);
        o[dt][1] = MFMA(vfr[kk][dt], pb[1][kk], o[dt][1]);
      }
  }
}
template <bool MASK>
struct AlibiInit {
  float sl, off0, off1;
  int lim0, lim1, win;
  __device__ __forceinline__ f32x4 operator()(int qt, int kt) const {
    const float off = qt ? off1 : off0;
    const int lim = qt ? lim1 : lim0;
    f32x4 c;
#pragma unroll
    for (int j = 0; j < 4; ++j) {
      const int kj = kt * 16 + j;
      float v = __builtin_fmaf(sl, (float)kj, off);
      if (MASK) v = (kj <= lim && kj > lim - win) ? v : -INFINITY;
      c[j] = v;
    }
    return c;
  }
};
__device__ __forceinline__ float ft_shift(float m) { return m < -1e29f ? 0.f : -m; }

struct NoHook { __device__ __forceinline__ void operator()(int, float (&)[4][4]) const {} };

struct IdMap { __device__ __forceinline__ int operator()(int t) const { return t; } };
template <int NKC, class KS, class KD, class VS, class Fn, class TM = IdMap>
__device__ __forceinline__ void flash_loop(int tb, int te, KS ksrc, KD kdst, VS vsrc, u16* Ks, u16* Vs, Fn fn, TM tmap = IdMap()) {
  const int tid = TIDX();
  u32x4 rk[NKC], rv[2];
  if (tb < te) {
    const int tt = tmap(tb);
#pragma unroll
    for (int i = 0; i < NKC; ++i) rk[i] = *(GAS const u32x4*)ksrc(tt, tid + i * 256);
#pragma unroll
    for (int i = 0; i < 2; ++i) rv[i] = *(GAS const u32x4*)vsrc(tt, tid + i * 256);
  }
  for (int t = tb; t < te; ++t) {
    __syncthreads();
#pragma unroll
    for (int i = 0; i < NKC; ++i) *(u32x4*)(Ks + kdst(tid + i * 256)) = rk[i];
#pragma unroll
    for (int i = 0; i < 2; ++i) { int c = tid + i * 256; *(u32x4*)(Vs + (c >> 3) * 72 + (c & 7) * 8) = rv[i]; }
    __syncthreads();
    if (t + 1 < te) {
      const int tt = tmap(t + 1);
#pragma unroll
      for (int i = 0; i < NKC; ++i) rk[i] = *(GAS const u32x4*)ksrc(tt, tid + i * 256);
#pragma unroll
      for (int i = 0; i < 2; ++i) rv[i] = *(GAS const u32x4*)vsrc(tt, tid + i * 256);
    }
    fn(tmap(t));
  }
}

__device__ __forceinline__ void tr_tile(const float* __restrict__ src, int ldsrc, u16* __restrict__ dst, int K, int N,
                                        int kt, int nt, const float* __restrict__ scale, bool cmap, char* smem, int sklim = 1 << 30) {
  float* tile = (float*)smem;
  const int tid = TIDX();
  const int nn = tid & 63, np = nt * 64 + nn;
  int oc = np;
  if (cmap) { if (np >= 1024 && np < 3104) oc = np + 4; else if (np >= 3104 && np < 3108) oc = np - 2080; }
  const bool inr = np < N;
  const float* col = src + (inr ? oc : 0);
  const int k0 = kt * 64 + (tid >> 6);
  float vals[16];
#pragma unroll
  for (int i = 0; i < 16; ++i) vals[i] = col[(long)(k0 + i * 4) * ldsrc];
  if (scale) {
#pragma unroll
    for (int i = 0; i < 16; ++i) { const int k = k0 + i * 4; vals[i] *= (k < sklim) ? scale[k < sklim ? k : 0] : 1.f; }
  }
  __syncthreads();
#pragma unroll
  for (int i = 0; i < 16; ++i) tile[(i * 4 + (tid >> 6)) * 65 + nn] = inr ? vals[i] : 0.f;
  __syncthreads();
#pragma unroll 4
  for (int i = 0; i < 16; ++i) {
    int n2 = i * 4 + (tid >> 6), kk = tid & 63;
    dst[(long)(nt * 64 + n2) * K + kt * 64 + kk] = f2bf(tile[kk * 65 + n2]);
  }
}

constexpr int TR_ITEMS = 3448;
__device__ __forceinline__ void weights_item(const Params& p, int layer, int it, char* smem) {
  char* ws = WSP(p);
  if (it < 800) { tr_tile(INP(p, I_WIN) + (long)layer * 1024 * 3120, 3120, (u16*)(ws + OFF_WT_IN), 1024, 3120, it % 16, it / 16, nullptr, true, smem); return; }
  it -= 800;
  if (it < 256) { tr_tile(INP(p, I_WOUT) + (long)layer * 1024 * 1024, 1024, (u16*)(ws + OFF_WT_OUT), 1024, 1024, it % 16, it / 16, INP(p, I_SSMG) + layer * 256, false, smem, 256); return; }
  it -= 256;
  if (it < 1024) { tr_tile(INP(p, I_WM1) + (long)layer * 1024 * 4096, 4096, (u16*)(ws + OFF_WT_M1), 1024, 4096, it % 16, it / 16, nullptr, false, smem); return; }
  it -= 1024;
  if (it < 1024) { tr_tile(INP(p, I_WM2) + (long)layer * 4096 * 1024, 1024, (u16*)(ws + OFF_WT_M2), 4096, 1024, it % 64, it / 64, nullptr, false, smem); return; }
  it -= 1024;
  if (it < 24) { tr_tile(INP(p, I_WUQ) + (long)layer * 256 * 384, 384, (u16*)(ws + OFF_WT_UQ), 256, 384, it % 4, it / 4, INP(p, I_QNG) + layer * 256, false, smem); return; }
  it -= 24;
  if (it < 16) { tr_tile(INP(p, I_WUKV) + (long)layer * 128 * 512, 512, (u16*)(ws + OFF_WT_UKV), 128, 512, it % 2, it / 2, INP(p, I_KVNG) + layer * 128, false, smem); return; }
  it -= 16;
  if (it < 128) { tr_tile(INP(p, I_W1K) + (long)layer * 2048 * 256, 256, (u16*)(ws + OFF_WT_C1K), 2048, 256, it % 32, it / 32, nullptr, false, smem); return; }
  it -= 128;
  if (it < 128) { tr_tile(INP(p, I_W1V) + (long)layer * 2048 * 256, 256, (u16*)(ws + OFF_WT_C1V), 2048, 256, it % 32, it / 32, nullptr, false, smem); return; }
  it -= 128;
  if (it < 8) { tr_tile(INP(p, I_W2K) + (long)layer * 256 * 64, 64, (u16*)(ws + OFF_WT_C2K), 256, 64, it % 4, it / 4, nullptr, false, smem); return; }
  it -= 8;
  if (it < 8) { tr_tile(INP(p, I_W2V) + (long)layer * 256 * 64, 64, (u16*)(ws + OFF_WT_C2V), 256, 64, it % 4, it / 4, nullptr, false, smem); return; }
  it -= 8;
  {
    int job = it >> 4, sp = it & 15, n = TIDX();
    const float* pe = (job ? INP(p, I_PEV) : INP(p, I_PEK)) + (long)layer * 2048;
    const float* w1 = (job ? INP(p, I_W1V) : INP(p, I_W1K)) + (long)layer * 2048 * 256;
    float a = 0.f;
    for (int kk = sp * 128; kk < sp * 128 + 128; ++kk) a += pe[kk] * w1[(long)kk * 256 + n];
    ((float*)(ws + OFF_BIASP))[(job * 16 + sp) * 256 + n] = a;
  }
}

__device__ __forceinline__ void rope_item(const Params& p, int it) {
  const int tid = TIDX();
  const int pos = it * 16 + (tid >> 4), i = tid & 15;
  float* cm = (float*)(WSP(p) + OFF_COSM); float* sm = (float*)(WSP(p) + OFF_SINM);
  float* cr = (float*)(WSP(p) + OFF_COSR); float* sr = (float*)(WSP(p) + OFF_SINR);
  const float L2T = 13.287712379549449f;
  {
    float inv = exp2f(-(float)(2 * i) / 32.f * L2T);
    float ang = (float)pos * inv;
    double ad = (double)ang;
    float r = (float)(ad - 6.283185307179586 * rint(ad * 0.15915494309189535));
    cm[pos * 16 + i] = __cosf(r); sm[pos * 16 + i] = __sinf(r);
  }
#pragma unroll
  for (int e = 0; e < 2; ++e) {
    int ii = i + e * 16;
    float inv = exp2f(-(float)(2 * ii) / 64.f * L2T);
    float ang = (float)pos * inv;
    double ad = (double)ang;
    float r = (float)(ad - 6.283185307179586 * rint(ad * 0.15915494309189535));
    cr[pos * 32 + ii] = __cosf(r); sr[pos * 32 + ii] = __sinf(r);
  }
}

__device__ __forceinline__ void ln_row(const float* src, const float* __restrict__ g, const float* __restrict__ bb,
                                       float* dst32, u16* __restrict__ dstbf, int row, float* stats = nullptr) {
  const int lane = TIDX() & 63;
  const float4* s4 = (const float4*)(src + (long)row * 1024);
  float4 v[4];
#pragma unroll
  for (int i = 0; i < 4; ++i) v[i] = s4[lane + 64 * i];
  float sm = 0.f;
#pragma unroll
  for (int i = 0; i < 4; ++i) sm += v[i].x + v[i].y + v[i].z + v[i].w;
  const float mean = wave_sum(sm) * (1.f / 1024.f);
  float vs = 0.f;
#pragma unroll
  for (int i = 0; i < 4; ++i) {
    float a = v[i].x - mean, b = v[i].y - mean, c = v[i].z - mean, d = v[i].w - mean;
    vs += a * a + b * b + c * c + d * d;
  }
  const float rstd = rsqrtf(wave_sum(vs) * (1.f / 1024.f) + EPS_);
  float4* d4 = (float4*)(dst32 + (long)row * 1024);
  u32x2* db = (u32x2*)(dstbf + (long)row * 1024);
#pragma unroll
  for (int i = 0; i < 4; ++i) {
    float4 gg = ((const float4*)g)[lane + 64 * i], b4 = ((const float4*)bb)[lane + 64 * i], o;
    o.x = (v[i].x - mean) * rstd * gg.x + b4.x;
    o.y = (v[i].y - mean) * rstd * gg.y + b4.y;
    o.z = (v[i].z - mean) * rstd * gg.z + b4.z;
    o.w = (v[i].w - mean) * rstd * gg.w + b4.w;
    if (dst32) d4[lane + 64 * i] = o;
    u32x2 pk; pk.x = pack2(o.x, o.y); pk.y = pack2(o.z, o.w);
    db[lane + 64 * i] = pk;
  }
  if (stats && lane == 0) { stats[row * 2] = mean; stats[row * 2 + 1] = rstd; }
}

__device__ __forceinline__ void phase0(const Params& p, int bid, int nb, char* smem) {
  if (bid == 0 && TIDX() < 64) ((int*)(WSP(p) + OFF_CNT))[TIDX()] = 0;
  const int total = TR_ITEMS + 512 + 4096;
  for (int it = bid; it < total; it += nb) {
    if (it < TR_ITEMS) weights_item(p, 0, it, smem);
    else if (it < TR_ITEMS + 512) rope_item(p, it - TR_ITEMS);
    else {
      int row = (it - TR_ITEMS - 512) * 4 + (TIDX() >> 6);
      ln_row(INP(p, I_X), INP(p, I_LNEG), INP(p, I_LNEB), p.h32, (u16*)(WSP(p) + OFF_HBF), row);
    }
  }
}

__device__ __forceinline__ void phase_ln(const Params& p, int bid, int nb, char* smem, const float* g, const float* b, int conv_layer, int slot, bool final_out) {
  const int nconv = conv_layer >= 0 ? TR_ITEMS : 0;
  const int total = nconv + 4096;
  for (int it = bid; it < total; it += nb) {
    if (it < nconv) weights_item(p, conv_layer, it, smem);
    else {
      int row = (it - nconv) * 4 + (TIDX() >> 6);
      float* st = (float*)(WSP(p) + OFF_LNST) + (long)slot * T_ * 2;
      if (final_out) ln_row(p.h32, g, b, p.h32, (u16*)(WSP(p) + OFF_HBF), row);
      else ln_row(p.h32, g, b, nullptr, (u16*)(WSP(p) + OFF_HBF), row, st);
    }
  }
}

__device__ __forceinline__ int xcd_tile(int t, int bid, int nb, int ntiles) {
  if (nb & 7) return t;
  const int pass = t - bid;
  const int chunk = nb >> 3;
  const int r = (bid & 7) * chunk + (bid >> 3) + pass;
  return ((pass + nb) <= ntiles) ? r : t;
}

__device__ __forceinline__ void phase_inproj(const Params& p, int bid, int nb, char* smem) {
  const u16* A = (const u16*)(WSP(p) + OFF_HBF);
  const u16* Bt = (const u16*)(WSP(p) + OFF_WT_IN);
  u16* out = (u16*)(WSP(p) + OFF_R + R_PROJ);
  for (int t0 = bid; t0 < 128 * 25; t0 += nb) {
    const int t = xcd_tile(t0, bid, nb, 128 * 25);
    const int mt = t / 25, nt = t % 25;
    const int m0 = mt * 128, n0 = nt * 128;
    gemm_tile<true>([&](int r) { return A + (long)(m0 + r) * 1024; }, 64, Bt, 1024, 1024, n0,
              [&](int r, int c, const f32x4& v) {
                u32x2 pk; pk.x = pack2(v[0], v[1]); pk.y = pack2(v[2], v[3]);
                *(u32x2*)(out + (long)(m0 + r) * DINP_ + n0 + c) = pk;
              }, (u16*)smem);
  }
}

template <bool SSDNORM>
__device__ __forceinline__ void phase_resgemm(const Params& p, int bid, int nb, char* smem, const u16* A, int K, const u16* Bt,
                                              const float* lnst, const float* lng, const float* lnb) {
  float* h = p.h32;
  float* rstd = (float*)(smem + 65536);
  float* rowst = (float*)(smem + 65536 + 512);
  const float* ssq = (const float*)(WSP(p) + OFF_SSQ);
  for (int t0 = bid; t0 < 128 * 8; t0 += nb) {
    const int t = xcd_tile(t0, bid, nb, 128 * 8);
    const int mt = t / 8, nt = t % 8;
    const int m0 = mt * 128, n0 = nt * 128;
    if (SSDNORM) {
      __syncthreads();
      const int tid = TIDX();
      if (tid < 128) {
        const f32x4 s4 = *(const f32x4*)(ssq + (long)(m0 + tid) * 4);
        rstd[tid] = rsqrtf((s4[0] + s4[1] + s4[2] + s4[3]) * (1.f / 256.f) + EPS_);
      }
      __syncthreads();
    }
    if (lnst) {
      __syncthreads();
      const int tid = TIDX();
      rowst[tid] = lnst[(long)m0 * 2 + tid];
      __syncthreads();
    }
    gemm_tile<true>([&](int r) { return A + (long)(m0 + r) * K; }, 64, Bt, K, K, n0,
              [&](int r, int c, const f32x4& v) {
                f32x4* q = (f32x4*)(h + (long)(m0 + r) * 1024 + n0 + c);
                f32x4 res = *q;
                if (lnst) {
                  const float mu = rowst[r * 2], rs = rowst[r * 2 + 1];
                  const f32x4 g4 = *(const f32x4*)(lng + n0 + c), b4 = *(const f32x4*)(lnb + n0 + c);
                  res = (res - mu) * rs * g4 + b4;
                }
                *q = ALPHA_ * res + v;
              }, (u16*)smem,
              [&](int kt, f32x4 (&acc)[4][4]) {
                if (SSDNORM && kt == 3) {
                  const int tid = TIDX(), wm = tid >> 7, lr = tid & 15;
#pragma unroll
                  for (int mi = 0; mi < 4; ++mi) {
                    const float rs = rstd[wm * 64 + mi * 16 + lr];
#pragma unroll
                    for (int ni = 0; ni < 4; ++ni) acc[mi][ni] *= rs;
                  }
                }
              });
  }
}

__device__ __forceinline__ void phase_mlp1(const Params& p, int bid, int nb, char* smem) {
  const u16* A = (const u16*)(WSP(p) + OFF_HBF);
  const u16* Bt = (const u16*)(WSP(p) + OFF_WT_M1);
  u16* out = (u16*)(WSP(p) + OFF_R);
  for (int t0 = bid; t0 < 128 * 32; t0 += nb) {
    int mt, nt;
    if (nb == 512) {
      const int pass = t0 >> 9, x = bid & 7, j = bid >> 3;
      const int s = pass * 8 + x;
      mt = (s >> 2) * 8 + (j >> 3);
      nt = (s & 3) * 8 + (j & 7);
    } else {
      const int t = xcd_tile(t0, bid, nb, 128 * 32);
      mt = t / 32; nt = t % 32;
    }
    const int m0 = mt * 128, n0 = nt * 128;
    gemm_tile<true>([&](int r) { return A + (long)(m0 + r) * 1024; }, 64, Bt, 1024, 1024, n0,
              [&](int r, int c, const f32x4& v) {
                const float x0 = fmaxf(v[0], 0.f), x1 = fmaxf(v[1], 0.f), x2 = fmaxf(v[2], 0.f), x3 = fmaxf(v[3], 0.f);
                u32x2 pk; pk.x = pack2(x0 * x0, x1 * x1); pk.y = pack2(x2 * x2, x3 * x3);
                *(u32x2*)(out + (long)(m0 + r) * DFF_ + n0 + c) = pk;
              }, (u16*)smem);
  }
}

__device__ __forceinline__ void conv8(const u16* __restrict__ proj, const float* __restrict__ cw, const float* __restrict__ cb,
                                      int b, int pos, int ch0, float (&out)[8]) {
  float acc[8];
#pragma unroll
  for (int i = 0; i < 8; ++i) acc[i] = cb[ch0 + i];
  U8 v[4];
#pragma unroll
  for (int j = 0; j < 4; ++j) {
    const int pp = pos - 3 + j;
    v[j].u = *(const u32x4*)(proj + (long)(b * S_ + (pp > 0 ? pp : 0)) * DINP_ + C_XS + ch0);
  }
#pragma unroll
  for (int j = 0; j < 4; ++j) {
    const float mk = (pos - 3 + j) >= 0 ? 1.f : 0.f;
    const float* w = cw + j * 768 + ch0;
#pragma unroll
    for (int i = 0; i < 8; ++i) acc[i] += (w[i] * mk) * bf2f(v[j].s[i]);
  }
#pragma unroll
  for (int i = 0; i < 8; ++i) out[i] = silu_f(acc[i]);
}

__device__ __forceinline__ void ssd_dt_setup(const Params& p, int layer, int b, int c, int h, float* dtv, float* acs, float* tmp) {
  const int tid = TIDX(), lane = tid & 63;
  const u16* proj = PROJ(p);
  __syncthreads();
  float a = 0.f;
  if (tid < 128) {
    float raw = bf2f(proj[(long)(b * S_ + c * 128 + tid) * DINP_ + C_DT + h]) + INP(p, I_DTB)[layer * 4 + h];
    float dt = raw > 20.f ? raw : log1pf(__expf(raw));
    dtv[tid] = dt;
    a = -dt * __expf(INP(p, I_ALOG)[layer * 4 + h]);
#pragma unroll
    for (int ofs = 1; ofs < 64; ofs <<= 1) {
      const float v = __shfl_up(a, ofs);
      if (lane >= ofs) a += v;
    }
    if (tid == 63) tmp[0] = a;
  }
  __syncthreads();
  if (tid < 128) acs[tid] = (tid >= 64) ? a + tmp[0] : a;
  __syncthreads();
}

__device__ __forceinline__ void ssd_state_item(const Params& p, int layer, int item, char* smem) {
  const int b = item >> 8, c = (item >> 2) & 63, h = item & 3, g = h >> 1;
  const int tid = TIDX(), lane = tid & 63, wave = tid >> 6, lr = lane & 15, quad = lane >> 4;
  u16* Xt = (u16*)smem;
  u16* Btr = Xt + 64 * TSTR;
  float* dtv = (float*)(smem + (64 + 128) * TSTR * 2);
  float* acs = dtv + 128;
  float* tmp = acs + 128;
  const u16* proj = PROJ(p);
  const float* cw = INP(p, I_CONVW) + layer * 4 * 768;
  const float* cb = INP(p, I_CONVB) + layer * 768;
  ssd_dt_setup(p, layer, b, c, h, dtv, acs, tmp);
  const float aend = acs[127];
#pragma unroll 2
  for (int i = 0; i < 4; ++i) {
    int cc = tid + i * 256, l = cc >> 3, p0 = (cc & 7) * 8;
    float o[8];
    conv8(proj, cw, cb, b, c * 128 + l, h * 64 + p0, o);
    const float w = dtv[l] * __expf(aend - acs[l]);
#pragma unroll
    for (int e = 0; e < 8; ++e) Xt[(p0 + e) * TSTR + l] = f2bf(o[e] * w);
  }
#pragma unroll 2
  for (int i = 0; i < 8; ++i) {
    int cc = tid + i * 256, l = cc >> 4, n0 = (cc & 15) * 8;
    float o[8];
    conv8(proj, cw, cb, b, c * 128 + l, 256 + g * 128 + n0, o);
#pragma unroll
    for (int e = 0; e < 8; ++e) Btr[(n0 + e) * TSTR + l] = f2bf(o[e]);
  }
  __syncthreads();
  f32x4 acc[4][2];
#pragma unroll
  for (int mi = 0; mi < 4; ++mi) { acc[mi][0] = (f32x4){0.f, 0.f, 0.f, 0.f}; acc[mi][1] = (f32x4){0.f, 0.f, 0.f, 0.f}; }
#pragma unroll
  for (int ks = 0; ks < 4; ++ks) {
    bf16x8 bb[2];
#pragma unroll
    for (int ni = 0; ni < 2; ++ni) bb[ni] = *(const bf16x8*)(Btr + (wave * 32 + ni * 16 + lr) * TSTR + ks * 32 + quad * 8);
#pragma unroll
    for (int mi = 0; mi < 4; ++mi) {
      bf16x8 a = *(const bf16x8*)(Xt + (mi * 16 + lr) * TSTR + ks * 32 + quad * 8);
      acc[mi][0] = MFMA(a, bb[0], acc[mi][0]);
      acc[mi][1] = MFMA(a, bb[1], acc[mi][1]);
    }
  }
  float* st = (float*)(WSP(p) + OFF_R + R_SSDST) + (long)((b * 64 + c) * 4 + h) * 8192;
#pragma unroll
  for (int mi = 0; mi < 4; ++mi)
#pragma unroll
    for (int ni = 0; ni < 2; ++ni)
#pragma unroll
      for (int j = 0; j < 4; ++j) st[(mi * 16 + quad * 4 + j) * 128 + wave * 32 + ni * 16 + lr] = acc[mi][ni][j];
  if (tid == 0) ((float*)(WSP(p) + OFF_SSDDEC))[(b * 64 + c) * 4 + h] = __expf(aend);
}

__device__ __forceinline__ void ret_rope8(const Params& p, const u16* __restrict__ proj, int col, int b, int pos, int d0, float scale, float (&out)[8]) {
  const u16* row = proj + (long)(b * S_ + pos) * DINP_ + col;
  const int i0 = d0 & 31;
  U8 x1, x2;
  x1.u = *(const u32x4*)(row + i0);
  x2.u = *(const u32x4*)(row + 32 + i0);
  const float* cr = (const float*)(WSP(p) + OFF_COSR) + pos * 32 + i0;
  const float* sr = (const float*)(WSP(p) + OFF_SINR) + pos * 32 + i0;
#pragma unroll
  for (int e = 0; e < 8; ++e) {
    float a = bf2f(x1.s[e]), bb = bf2f(x2.s[e]), cc = cr[e], ss = sr[e];
    out[e] = (d0 < 32 ? (a * cc - bb * ss) : (a * ss + bb * cc)) * scale;
  }
}

__device__ __forceinline__ float ret_loggamma(int h) { return log1pf(-exp2f(-5.f - (float)h)); }

__device__ __forceinline__ void ret_state_item(const Params& p, int layer, int item, char* smem) {
  const int b = item >> 8, c = (item >> 2) & 63, h = item & 3;
  const int tid = TIDX(), lane = tid & 63, wave = tid >> 6, lr = lane & 15, quad = lane >> 4;
  u16* Vt = (u16*)smem;
  u16* Kt = Vt + 64 * TSTR;
  const u16* proj = PROJ(p);
  const float lg = ret_loggamma(h);
  __syncthreads();
#pragma unroll 2
  for (int i = 0; i < 4; ++i) {
    int cc = tid + i * 256, l = cc >> 3, v0 = (cc & 7) * 8;
    U8 x; x.u = *(const u32x4*)(proj + (long)(b * S_ + c * 128 + l) * DINP_ + C_RV + h * 64 + v0);
    const float z = __expf((float)(127 - l) * lg);
#pragma unroll
    for (int e = 0; e < 8; ++e) Vt[(v0 + e) * TSTR + l] = f2bf(bf2f(x.s[e]) * z);
  }
#pragma unroll 2
  for (int i = 0; i < 4; ++i) {
    int cc = tid + i * 256, l = cc >> 3, d0 = (cc & 7) * 8;
    float o[8];
    ret_rope8(p, proj, C_RK + h * 64, b, c * 128 + l, d0, 0.125f, o);
#pragma unroll
    for (int e = 0; e < 8; ++e) Kt[(d0 + e) * TSTR + l] = f2bf(o[e]);
  }
  __syncthreads();
  f32x4 acc[4];
#pragma unroll
  for (int mi = 0; mi < 4; ++mi) acc[mi] = (f32x4){0.f, 0.f, 0.f, 0.f};
#pragma unroll
  for (int ks = 0; ks < 4; ++ks) {
    bf16x8 bb = *(const bf16x8*)(Kt + (wave * 16 + lr) * TSTR + ks * 32 + quad * 8);
#pragma unroll
    for (int mi = 0; mi < 4; ++mi) {
      bf16x8 a = *(const bf16x8*)(Vt + (mi * 16 + lr) * TSTR + ks * 32 + quad * 8);
      acc[mi] = MFMA(a, bb, acc[mi]);
    }
  }
  float* st = (float*)(WSP(p) + OFF_R + R_RETST) + (long)((b * 64 + c) * 4 + h) * 4096;
#pragma unroll
  for (int mi = 0; mi < 4; ++mi)
#pragma unroll
    for (int j = 0; j < 4; ++j) st[(mi * 16 + quad * 4 + j) * 64 + wave * 16 + lr] = acc[mi][j];
}

__device__ __forceinline__ void mla_up_item(const Params& p, int which, int t, char* smem) {
  const int tid = TIDX();
  const u16* proj = PROJ(p);
  float* rstd = (float*)(smem + 65536);
  const int K = which ? 128 : 256, nnt = which ? 4 : 3;
  const int mt = t / nnt, nt = t % nnt, m0 = mt * 128, n0 = nt * 128;
  const int col = which ? C_CKV : C_CQ;
  __syncthreads();
  {
    const int r = tid >> 1, hf = tid & 1, n = K / 2;
    const u16* src = proj + (long)(m0 + r) * DINP_ + col + hf * n;
    float ss = 0.f;
    for (int i = 0; i < n; i += 8) {
      U8 x; x.u = *(const u32x4*)(src + i);
#pragma unroll
      for (int e = 0; e < 8; ++e) { float f = bf2f(x.s[e]); ss += f * f; }
    }
    ss += __shfl_xor(ss, 1);
    if (hf == 0) rstd[r] = rsqrtf(ss / (float)K + EPS_);
  }
  __syncthreads();
  if (which == 0) {
    u16* q = (u16*)(WSP(p) + OFF_QMLA);
    const float sc = 0.10206207261596575f * 1.4426950408889634f;
    gemm_tile<true>([&](int r) { return proj + (long)(m0 + r) * DINP_ + col; }, 64, (const u16*)(WSP(p) + OFF_WT_UQ), 256, 256, n0,
              [&](int r, int c, const f32x4& v) {
                const float rs = rstd[r] * sc;
                u32x2 pk; pk.x = pack2(v[0] * rs, v[1] * rs); pk.y = pack2(v[2] * rs, v[3] * rs);
                *(u32x2*)(q + (long)(m0 + r) * 384 + n0 + c) = pk;
              }, (u16*)smem);
  } else {
    u16* kb = (u16*)(WSP(p) + OFF_KBUF);
    u16* vt = (u16*)(WSP(p) + OFF_VTMLA);
    gemm_tile<false>([&](int r) { return proj + (long)(m0 + r) * DINP_ + col; }, 64, (const u16*)(WSP(p) + OFF_WT_UKV), 128, 128, n0,
              [&](int r, int c, const f32x4& v) {
                const int n = n0 + c, hh = n >> 7, d = n & 127;
                if (d < 64) {
#pragma unroll
                  for (int j = 0; j < 4; ++j) kb[(long)(m0 + r + j) * 384 + hh * 96 + d] = f2bf(v[j] * rstd[r + j]);
                } else {
                  const int tok = m0 + r, bb = tok >> 13, pos = tok & 8191;
                  u32x2 pk;
                  pk.x = pack2(v[0] * rstd[r], v[1] * rstd[r + 1]);
                  pk.y = pack2(v[2] * rstd[r + 2], v[3] * rstd[r + 3]);
                  *(u32x2*)(vt + ((long)(bb * 4 + hh) * 64 + (d - 64)) * 8192 + pos) = pk;
                }
              }, (u16*)smem);
  }
}

__device__ __forceinline__ void kpe_item(const Params& p, int it) {
  const int tid = TIDX();
  const u16* proj = PROJ(p);
  u16* kb = (u16*)(WSP(p) + OFF_KBUF);
  const float* cm = (const float*)(WSP(p) + OFF_COSM);
  const float* sm = (const float*)(WSP(p) + OFF_SINM);
#pragma unroll 4
  for (int e = 0; e < 8; ++e) {
    int idx = tid + e * 256;
    int tok = it * 128 + (idx >> 4), i = idx & 15, pos = tok & 8191;
    const u16* row = proj + (long)tok * DINP_ + C_KR;
    float x1 = bf2f(row[i]), x2 = bf2f(row[16 + i]);
    float c = cm[pos * 16 + i], s = sm[pos * 16 + i];
    u16 y1 = f2bf(x1 * c - x2 * s), y2 = f2bf(x1 * s + x2 * c);
#pragma unroll
    for (int hh = 0; hh < 4; ++hh) { kb[(long)tok * 384 + hh * 96 + 64 + i] = y1; kb[(long)tok * 384 + hh * 96 + 80 + i] = y2; }
  }
}

__device__ __forceinline__ void vtrans_item(const Params& p, int it, char* smem) {
  const int which = it >> 8, blk = it & 255, b = blk >> 7, t0 = (blk & 127) * 64;
  const int tid = TIDX();
  const u16* proj = PROJ(p);
  u16* tile = (u16*)smem;
  u16* dst = (u16*)(WSP(p) + (which ? OFF_VWT : OFF_VST));
  const int col = which ? C_NVW : C_NVS;
  __syncthreads();
#pragma unroll
  for (int i = 0; i < 2; ++i) {
    int c = tid + i * 256, tok = c >> 3, ch = c & 7;
    *(u32x4*)(tile + tok * 72 + ch * 8) = *(const u32x4*)(proj + (long)(b * S_ + t0 + tok) * DINP_ + col + ch * 8);
  }
  __syncthreads();
#pragma unroll
  for (int i = 0; i < 2; ++i) {
    int c = tid + i * 256, d = c >> 3, tch = c & 7;
    U8 o;
#pragma unroll
    for (int e = 0; e < 8; ++e) o.s[e] = tile[(tch * 8 + e) * 72 + d];
    *(u32x4*)(dst + (long)(b * 64 + d) * 8192 + t0 + tch * 8) = o.u;
  }
}

__device__ __forceinline__ void cmp_hid_item(const Params& p, int t, char* smem) {
  const int job = t >> 4, mt = (t >> 1) & 7, nt = t & 1, m0 = mt * 128, n0 = nt * 128;
  const u16* proj = PROJ(p);
  const int col = job ? C_NVC : C_NKC;
  u16* hid = (u16*)(WSP(p) + OFF_R + R_HID) + (long)job * 1024 * 256;
  const float* bp = (const float*)(WSP(p) + OFF_BIASP) + job * 16 * 256;
  float* bl = (float*)(smem + 65536);
  __syncthreads();
  if (TIDX() < 128) {
    float bias = 0.f;
#pragma unroll
    for (int s = 0; s < 16; ++s) bias += bp[s * 256 + n0 + TIDX()];
    bl[TIDX()] = bias;
  }
  __syncthreads();
  gemm_tile<true>([&](int r) { int rr = m0 + r; return proj + (long)((rr >> 9) * S_ + (rr & 511) * 16) * DINP_ + col; }, DINP_,
            (const u16*)(WSP(p) + (job ? OFF_WT_C1V : OFF_WT_C1K)), 2048, 2048, n0,
            [&](int r, int c, const f32x4& v) {
              const f32x4 b4 = *(const f32x4*)(bl + c);
              u32x2 pk;
              pk.x = pack2(silu_f(v[0] + b4[0]), silu_f(v[1] + b4[1]));
              pk.y = pack2(silu_f(v[2] + b4[2]), silu_f(v[3] + b4[3]));
              *(u32x2*)(hid + (long)(m0 + r) * 256 + n0 + c) = pk;
            }, (u16*)smem);
}

__device__ __forceinline__ int next_item_xcd(int* cnt8, int per, int& qx, char* smem) {
  int* sh = (int*)(smem + SMEM_BYTES - 16);
  __syncthreads();
  if (TIDX() == 0) {
    int res = -1;
    const int x0 = (int)((unsigned)__builtin_amdgcn_s_getreg((3 << 11) | 20) & 7u);
    int d = atomicAdd(cnt8 + x0, 1);
    if (d < per) res = x0 * 65536 + d;
    else {
      int c[8];
#pragma unroll
      for (int s = 0; s < 8; ++s) c[s] = __hip_atomic_load(cnt8 + s, __ATOMIC_RELAXED, __HIP_MEMORY_SCOPE_AGENT);
#pragma unroll
      for (int s = 1; s < 8; ++s) {
        const int x = (x0 + s) & 7;
        int cx = 0;
#pragma unroll
        for (int q = 0; q < 8; ++q) cx = (q == x) ? c[q] : cx;
        if (res < 0 && cx < per) { d = atomicAdd(cnt8 + x, 1); if (d < per) res = x * 65536 + d; }
      }
    }
    *sh = res;
  }
  __syncthreads();
  const int r = *sh;
  qx = r >> 16;
  return r < 0 ? -1 : (r & 65535);
}
#define QLOOP_X(C8, PER, CALL)                                            \
  for (;;) {                                                              \
    int qx;                                                               \
    const int qd = next_item_xcd(cnt + (C8), (PER), qx, smem);            \
    if (qd < 0) break;                                                    \
    CALL;                                                                 \
  }
#define QLOOP(CIDX, N, CALL)                                              \
  for (;;) {                                                              \
    const int it = next_item(cnt + (CIDX), smem);                         \
    if (it >= (N)) break;                                                 \
    CALL;                                                                 \
  }
__device__ __forceinline__ void phase2(const Params& p, int layer, char* smem) {
  int* cnt = (int*)(WSP(p) + OFF_CNT) + layer * 16;
  QLOOP(0, 32, cmp_hid_item(p, it, smem))
  QLOOP(1, 512, ssd_state_item(p, layer, it, smem))
  QLOOP(2, 512, ret_state_item(p, layer, it, smem))
  QLOOP(3, 384, mla_up_item(p, 0, it, smem))
  QLOOP(4, 512, mla_up_item(p, 1, it, smem))
  QLOOP(5, 128, kpe_item(p, it))
  QLOOP(6, 512, vtrans_item(p, it, smem))
}


struct MlaTab { unsigned char qb[160], c[160]; };
constexpr MlaTab make_mla_tab() {
  MlaTab t{};
  int n = 0;
  for (int qb = 63; qb >= 0; --qb) { const int nt = 2 * qb + 2; for (int c = 0; c < nt / 32; ++c) { t.qb[n] = (unsigned char)qb; t.c[n] = (unsigned char)c; ++n; } }
  for (int rem = 30; rem >= 2; rem -= 2)
    for (int qb = 63; qb >= 0; --qb) { const int nt = 2 * qb + 2; if (nt % 32 == rem) { t.qb[n] = (unsigned char)qb; t.c[n] = (unsigned char)(nt / 32); ++n; } }
  return t;
}
__device__ const MlaTab g_mla_tab = make_mla_tab();
__device__ __forceinline__ int mla_slot(int bh, int qb, int c) { const int k = qb >> 4, r = qb & 15; return bh * 160 + 8 * k * (k + 1) + r * (k + 1) + c; }

__device__ __forceinline__ void mla_item(const Params& p, int item, char* smem) {
  const int un = item >> 3, bh = item & 7, b = bh >> 2, h = bh & 3;
  const int qb = g_mla_tab.qb[un], ch = g_mla_tab.c[un];
  const int tid = TIDX(), lane = tid & 63, wave = tid >> 6, lr = lane & 15, quad = lane >> 4;
  u16* Ks = (u16*)smem;
  u16* Vs = Ks + 64 * 104;
  const u16* qm = (const u16*)(WSP(p) + OFF_QMLA);
  const u16* kb = (const u16*)(WSP(p) + OFF_KBUF);
  const u16* vt = (const u16*)(WSP(p) + OFF_VTMLA) + (long)(b * 4 + h) * 64 * 8192;
  const float* cm = (const float*)(WSP(p) + OFF_COSM);
  const float* sm = (const float*)(WSP(p) + OFF_SINM);
  int tq[2];
  bf16x8 qf[3][2];
#pragma unroll
  for (int qt = 0; qt < 2; ++qt) {
    tq[qt] = qb * 128 + wave * 32 + qt * 16 + lr;
    const u16* qrow = qm + (long)(b * S_ + tq[qt]) * 384 + h * 96;
    qf[0][qt] = *(const bf16x8*)(qrow + quad * 8);
    qf[1][qt] = *(const bf16x8*)(qrow + 32 + quad * 8);
    U8 x, xp, o;
    x.u = *(const u32x4*)(qrow + 64 + quad * 8);
    xp.u = *(const u32x4*)(qrow + 64 + (quad ^ 2) * 8);
    const int i0 = (quad & 1) * 8;
#pragma unroll
    for (int e = 0; e < 8; ++e) {
      float c = cm[tq[qt] * 16 + i0 + e], s = sm[tq[qt] * 16 + i0 + e];
      float a = bf2f(x.s[e]), bb = bf2f(xp.s[e]);
      o.s[e] = f2bf(quad < 2 ? (a * c - bb * s) : (bb * s + a * c));
    }
    qf[2][qt] = o.v;
  }
  f32x4 o[4][2];
#pragma unroll
  for (int dt = 0; dt < 4; ++dt) { o[dt][0] = (f32x4){0.f, 0.f, 0.f, 0.f}; o[dt][1] = (f32x4){0.f, 0.f, 0.f, 0.f}; }
  float m[2] = {-1e30f, -1e30f}, l[2] = {0.f, 0.f};
  const int nt = 2 * qb + 2, nch = (nt + 31) >> 5;
  const int tb = ch * 32, te = (tb + 32 < nt) ? tb + 32 : nt;
  auto kf = [&](int kt, int ks) { return *(const bf16x8*)(Ks + (kt * 16 + lr) * 104 + ks * 32 + quad * 8); };
  auto vf = [&](int dt, int kk) {
    U8 u;
    u.d[0] = *(const u64*)(Vs + (dt * 16 + lr) * 72 + kk * 32 + quad * 4);
    u.d[1] = *(const u64*)(Vs + (dt * 16 + lr) * 72 + kk * 32 + 16 + quad * 4);
    return u.v;
  };
  flash_loop<3>(tb, te,
      [&](int t, int c) { int key = c / 12, cc = c % 12; return kb + (long)(b * S_ + t * 64 + key) * 384 + h * 96 + cc * 8; },
      [&](int c) { int key = c / 12, cc = c % 12; return key * 104 + cc * 8; },
      [&](int t, int c) { return vt + (long)(c >> 3) * 8192 + t * 64 + (c & 7) * 8; },
      Ks, Vs,
      [&](int t) {
        if (t == nt - 1 && wave < 2) return;
        const float sh0 = ft_shift(m[0]), sh1 = ft_shift(m[1]);
        if (t >= nt - 2) {
          const int lim0 = tq[0] - t * 64 - quad * 4, lim1 = tq[1] - t * 64 - quad * 4;
          flash_tile2<3, true>(kf, vf, [=](int qt, int kt) {
            const int lim = qt ? lim1 : lim0;
            const float sh = qt ? sh1 : sh0;
            f32x4 c;
#pragma unroll
            for (int j = 0; j < 4; ++j) c[j] = (kt * 16 + j <= lim) ? sh : -INFINITY;
            return c;
          }, NoHook(), qf, o, m, l);
        } else {
          flash_tile2<3, true>(kf, vf, [=](int qt, int) { const float sh = qt ? sh1 : sh0; return (f32x4){sh, sh, sh, sh}; }, NoHook(), qf, o, m, l);
        }
      });
  u16* mix = (u16*)(WSP(p) + OFF_HBF);
  const int slot = mla_slot(bh, qb, ch);
  u16* pO = (u16*)(WSP(p) + OFF_MLAP) + (long)slot * 8192;
  float* pML = (float*)(WSP(p) + OFF_MLAML) + (long)slot * 256;
#pragma unroll
  for (int qt = 0; qt < 2; ++qt) {
    float lt = l[qt];
    lt += __shfl_xor(lt, 16);
    lt += __shfl_xor(lt, 32);
    const float inv = 1.f / lt;
    const int ql = wave * 32 + qt * 16 + lr;
    u16* orow = (nch == 1) ? mix + (long)(b * S_ + tq[qt]) * 1024 + 256 + h * 64 : pO + ql * 64;
#pragma unroll
    for (int dt = 0; dt < 4; ++dt) {
      u32x2 pk;
      pk.x = pack2(o[dt][qt][0] * inv, o[dt][qt][1] * inv);
      pk.y = pack2(o[dt][qt][2] * inv, o[dt][qt][3] * inv);
      *(u32x2*)(orow + dt * 16 + quad * 4) = pk;
    }
    if (nch > 1 && quad == 0) { pML[ql * 2] = m[qt]; pML[ql * 2 + 1] = lt; }
  }
}

__device__ __forceinline__ void mla_combine_item(const Params& p, int ci) {
  const int bh = ci & 7, qb = 63 - (ci >> 3), b = bh >> 2, h = bh & 3;
  const int nch = (2 * qb + 2 + 31) >> 5;
  const int tid = TIDX(), q = tid >> 1, hf = tid & 1;
  const int slot0 = mla_slot(bh, qb, 0);
  const u16* pO = (const u16*)(WSP(p) + OFF_MLAP) + (long)slot0 * 8192 + q * 64 + hf * 32;
  const float* pML = (const float*)(WSP(p) + OFF_MLAML) + (long)slot0 * 256 + q * 2;
  float mc[4], lc[4], M = -1e30f;
#pragma unroll
  for (int c = 0; c < 4; ++c) {
    mc[c] = -1e30f; lc[c] = 0.f;
    if (c < nch) { mc[c] = pML[c * 256]; lc[c] = pML[c * 256 + 1]; }
    M = fmaxf(M, mc[c]);
  }
  float w[4], W = 0.f;
#pragma unroll
  for (int c = 0; c < 4; ++c) { w[c] = (c < nch) ? __builtin_amdgcn_exp2f(mc[c] - M) * lc[c] : 0.f; W += w[c]; }
  const float iW = 1.f / W;
  float acc[32];
#pragma unroll
  for (int e = 0; e < 32; ++e) acc[e] = 0.f;
#pragma unroll
  for (int c = 0; c < 4; ++c) {
    if (c < nch) {
      const float wc = w[c] * iW;
#pragma unroll
      for (int g = 0; g < 4; ++g) {
        U8 x; x.u = *(const u32x4*)(pO + (long)c * 8192 + g * 8);
#pragma unroll
        for (int e = 0; e < 8; ++e) acc[g * 8 + e] += wc * bf2f(x.s[e]);
      }
    }
  }
  u16* orow = (u16*)(WSP(p) + OFF_HBF) + (long)(b * S_ + qb * 128 + q) * 1024 + 256 + h * 64 + hf * 32;
#pragma unroll
  for (int g = 0; g < 4; ++g) {
    U8 o;
#pragma unroll
    for (int e = 0; e < 4; ++e) o.w[e] = pack2(acc[g * 8 + 2 * e], acc[g * 8 + 2 * e + 1]);
    *(u32x4*)(orow + g * 8) = o.u;
  }
}

__device__ __forceinline__ void cmp_out_item(const Params& p, int t, char* smem) {
  const int job = t >> 3, mt = t & 7, m0 = mt * 128;
  const u16* hid = (const u16*)(WSP(p) + OFF_R + R_HID) + (long)job * 1024 * 256;
  u16* kc = (u16*)(WSP(p) + OFF_R + R_KCMP);
  u16* vct = (u16*)(WSP(p) + OFF_R + R_VCT);
  gemm_tile<false>([&](int r) { return hid + (long)(m0 + r) * 256; }, 64, (const u16*)(WSP(p) + (job ? OFF_WT_C2V : OFF_WT_C2K)), 256, 256, 0,
            [&](int r, int c, const f32x4& v) {
              if (c < 64) {
                if (job == 0) {
#pragma unroll
                  for (int j = 0; j < 4; ++j) kc[(long)(m0 + r + j) * 64 + c] = f2bf(v[j]);
                } else {
                  const int rr = m0 + r, bb = rr >> 9, i = rr & 511;
                  u32x2 pk; pk.x = pack2(v[0], v[1]); pk.y = pack2(v[2], v[3]);
                  *(u32x2*)(vct + (long)(bb * 64 + c) * 512 + i) = pk;
                }
              }
            }, (u16*)smem);
}

__device__ __forceinline__ void scan_item(const Params& p, int it) {
  const int tid = TIDX();
  if (it < 256) {
    const int e = it * 256 + tid, b = e >> 15, h = (e >> 13) & 3, pn = e & 8191;
    float* st = (float*)(WSP(p) + OFF_R + R_SSDST) + (long)(b * 64 * 4 + h) * 8192 + pn;
    const float* dec = (const float*)(WSP(p) + OFF_SSDDEC) + b * 64 * 4 + h;
    float run = 0.f;
#pragma unroll 1
    for (int c0 = 0; c0 < 64; c0 += 16) {
      float s[16], d[16];
#pragma unroll
      for (int i = 0; i < 16; ++i) { s[i] = st[(long)(c0 + i) * 4 * 8192]; d[i] = dec[(c0 + i) * 4]; }
#pragma unroll
      for (int i = 0; i < 16; ++i) { const float prev = run; run = run * d[i] + s[i]; s[i] = prev; }
#pragma unroll
      for (int i = 0; i < 16; ++i) st[(long)(c0 + i) * 4 * 8192] = s[i];
    }
  } else {
    const int e = (it - 256) * 256 + tid, b = e >> 14, h = (e >> 12) & 3, vd = e & 4095;
    float* st = (float*)(WSP(p) + OFF_R + R_RETST) + (long)(b * 64 * 4 + h) * 4096 + vd;
    const float d = __expf(128.f * ret_loggamma(h));
    float run = 0.f;
#pragma unroll 1
    for (int c0 = 0; c0 < 64; c0 += 16) {
      float s[16];
#pragma unroll
      for (int i = 0; i < 16; ++i) s[i] = st[(long)(c0 + i) * 4 * 4096];
#pragma unroll
      for (int i = 0; i < 16; ++i) { const float prev = run; run = run * d + s[i]; s[i] = prev; }
#pragma unroll
      for (int i = 0; i < 16; ++i) st[(long)(c0 + i) * 4 * 4096] = s[i];
    }
  }
}

__device__ __forceinline__ void phase3(const Params& p, int layer, char* smem) {
  int* cnt = (int*)(WSP(p) + OFF_CNT) + layer * 16;
  QLOOP(7, 1280, mla_item(p, it, smem))
  QLOOP(8, 16, cmp_out_item(p, it, smem))
  QLOOP(9, 384, scan_item(p, it))
}

__device__ __forceinline__ void ssd_out_item(const Params& p, int layer, int item, char* smem) {
  const int b = item >> 8, c = (item >> 2) & 63, h = item & 3;
  const int tid = TIDX(), lane = tid & 63, wave = tid >> 6, lr = lane & 15, quad = lane >> 4;
  u16* Bs = (u16*)smem;
  u16* Xt = Bs + 128 * TSTR;
  u16* Sc = Xt + 64 * TSTR;
  float* dtv = (float*)(smem + (128 + 64 + 64) * TSTR * 2);
  float* acs = dtv + 128;
  float* tmp = acs + 128;
  float* ssq = tmp + 128;
  const u16* proj = PROJ(p);
  u16* mix = (u16*)(WSP(p) + OFF_HBF);
  const float* cw = INP(p, I_CONVW) + layer * 4 * 768;
  const float* cb = INP(p, I_CONVB) + layer * 768;
  float* ssqg = (float*)(WSP(p) + OFF_SSQ);
  (void)ssq;
  {
    const int g = h >> 1;
    ssd_dt_setup(p, layer, b, c, h, dtv, acs, tmp);
#pragma unroll 2
    for (int i = 0; i < 8; ++i) {
      int cc = tid + i * 256, l = cc >> 4, n0 = (cc & 15) * 8;
      float o[8];
      conv8(proj, cw, cb, b, c * 128 + l, 256 + g * 128 + n0, o);
      U8 u;
#pragma unroll
      for (int e = 0; e < 4; ++e) u.w[e] = pack2(o[2 * e], o[2 * e + 1]);
      *(u32x4*)(Bs + l * TSTR + n0) = u.u;
    }
#pragma unroll 2
    for (int i = 0; i < 4; ++i) {
      int cc = tid + i * 256, l = cc >> 3, p0 = (cc & 7) * 8;
      float o[8];
      conv8(proj, cw, cb, b, c * 128 + l, h * 64 + p0, o);
#pragma unroll
      for (int e = 0; e < 8; ++e) Xt[(p0 + e) * TSTR + l] = f2bf(o[e]);
    }
    __syncthreads();
    const float dsk = INP(p, I_DSKIP)[layer * 4 + h];
    const float* prev = (const float*)(WSP(p) + OFF_R + R_SSDST) + (long)((b * 64 + c) * 4 + h) * 8192;
#pragma unroll 1
    for (int pass = 0; pass < 2; ++pass) {
      const int row0 = pass * 64 + wave * 16;
      const int nlim = pass * 4 + wave + 1;
      bf16x8 cf[4];
#pragma unroll
      for (int ks = 0; ks < 4; ++ks) {
        float o[8];
        conv8(proj, cw, cb, b, c * 128 + row0 + lr, 512 + g * 128 + ks * 32 + quad * 8, o);
        U8 u;
#pragma unroll
        for (int e = 0; e < 4; ++e) u.w[e] = pack2(o[2 * e], o[2 * e + 1]);
        cf[ks] = u.v;
      }
#pragma unroll
      for (int ni = 0; ni < 8; ++ni) {
        if (ni < nlim) {
          f32x4 ga = (f32x4){0.f, 0.f, 0.f, 0.f};
#pragma unroll
          for (int ks = 0; ks < 4; ++ks) {
            bf16x8 bb = *(const bf16x8*)(Bs + (ni * 16 + lr) * TSTR + ks * 32 + quad * 8);
            ga = MFMA(cf[ks], bb, ga);
          }
          const int s = ni * 16 + lr;
          const float as = acs[s], ds = dtv[s];
#pragma unroll
          for (int j = 0; j < 4; ++j) {
            const int l = row0 + quad * 4 + j;
            float v = (s <= l) ? ga[j] * __expf(acs[l] - as) * ds : 0.f;
            Sc[(wave * 16 + quad * 4 + j) * TSTR + s] = f2bf(v);
          }
        } else if (ni == nlim) {
#pragma unroll
          for (int j = 0; j < 4; ++j) Sc[(wave * 16 + quad * 4 + j) * TSTR + ni * 16 + lr] = 0;
        }
      }
      f32x4 y[4];
#pragma unroll
      for (int ni = 0; ni < 4; ++ni) y[ni] = (f32x4){0.f, 0.f, 0.f, 0.f};
#pragma unroll
      for (int ks = 0; ks < 4; ++ks)
#pragma unroll
        for (int ni = 0; ni < 4; ++ni) {
          const float4* pp = (const float4*)(prev + (ni * 16 + lr) * 128 + ks * 32 + quad * 8);
          float4 f0 = pp[0], f1 = pp[1];
          U8 u;
          u.w[0] = pack2(f0.x, f0.y); u.w[1] = pack2(f0.z, f0.w); u.w[2] = pack2(f1.x, f1.y); u.w[3] = pack2(f1.z, f1.w);
          y[ni] = MFMA(cf[ks], u.v, y[ni]);
        }
#pragma unroll
      for (int j = 0; j < 4; ++j) {
        const float e = __expf(acs[row0 + quad * 4 + j]);
#pragma unroll
        for (int ni = 0; ni < 4; ++ni) y[ni][j] *= e;
      }
      asm volatile("s_waitcnt lgkmcnt(0)" ::: "memory");
#pragma unroll
      for (int ks = 0; ks < 4; ++ks) {
        if (ks * 2 < nlim) {
          bf16x8 a0 = *(const bf16x8*)(Sc + (wave * 16 + lr) * TSTR + ks * 32 + quad * 8);
#pragma unroll
          for (int ni = 0; ni < 4; ++ni) {
            bf16x8 bb = *(const bf16x8*)(Xt + (ni * 16 + lr) * TSTR + ks * 32 + quad * 8);
            y[ni] = MFMA(a0, bb, y[ni]);
          }
        }
      }
#pragma unroll
      for (int j = 0; j < 4; ++j) {
        const int l = row0 + quad * 4 + j;
        const long tok = (long)b * S_ + c * 128 + l;
        float sq = 0.f;
#pragma unroll
        for (int ni = 0; ni < 4; ++ni) {
          const int pp = ni * 16 + lr;
          float yv = y[ni][j] + bf2f(Xt[pp * TSTR + l]) * dsk;
          yv *= silu_f(bf2f(proj[tok * DINP_ + C_Z + h * 64 + pp]));
          const u16 yb = f2bf(yv);
          const float yr = bf2f(yb);
          sq += yr * yr;
          mix[tok * 1024 + h * 64 + pp] = yb;
        }
        sq += __shfl_xor(sq, 1); sq += __shfl_xor(sq, 2); sq += __shfl_xor(sq, 4); sq += __shfl_xor(sq, 8);
        if (lr == 0) ssqg[tok * 4 + h] = sq;
      }
    }
  }
#if 0
  const float* gn = INP(p, I_SSMG) + layer * 256;
#pragma unroll 1
  for (int i = 0; i < 16; ++i) {
    int cc = tid + i * 256, l = cc >> 5, c0 = (cc & 31) * 8;
    const float rs = rsqrtf(ssq[l] * (1.f / 256.f) + EPS_);
    u64* ptr = (u64*)(mix + ((long)b * S_ + c * 128 + l) * 1024 + c0);
    U8 x;
    x.d[0] = __hip_atomic_load(ptr, __ATOMIC_RELAXED, __HIP_MEMORY_SCOPE_AGENT);
    x.d[1] = __hip_atomic_load(ptr + 1, __ATOMIC_RELAXED, __HIP_MEMORY_SCOPE_AGENT);
    U8 o;
#pragma unroll
    for (int e = 0; e < 8; ++e) o.s[e] = f2bf(bf2f(x.s[e]) * rs * gn[c0 + e]);
    *(u32x4*)ptr = o.u;
  }
#endif
}

__device__ __forceinline__ void ret_out_item(const Params& p, int layer, int item, char* smem) {
  const int b = item >> 8, c = (item >> 2) & 63, h = item & 3;
  const int tid = TIDX(), lane = tid & 63, wave = tid >> 6, lr = lane & 15, quad = lane >> 4;
  u16* Sc = (u16*)smem;
  u16* Kr = Sc;
  u16* Vt = Sc + 128 * TSTR;
  const u16* proj = PROJ(p);
  const float lg = ret_loggamma(h);
  bf16x8 qf[2][2];
#pragma unroll
  for (int mi = 0; mi < 2; ++mi)
#pragma unroll
    for (int ks = 0; ks < 2; ++ks) {
      float o[8];
      ret_rope8(p, proj, C_RQ + h * 64, b, c * 128 + wave * 32 + mi * 16 + lr, ks * 32 + quad * 8, 1.f, o);
      U8 u;
#pragma unroll
      for (int e = 0; e < 4; ++e) u.w[e] = pack2(o[2 * e], o[2 * e + 1]);
      qf[mi][ks] = u.v;
    }
  __syncthreads();
#pragma unroll 2
  for (int i = 0; i < 4; ++i) {
    int cc = tid + i * 256, l = cc >> 3, d0 = (cc & 7) * 8;
    float o[8];
    ret_rope8(p, proj, C_RK + h * 64, b, c * 128 + l, d0, 0.125f, o);
    U8 u;
#pragma unroll
    for (int e = 0; e < 4; ++e) u.w[e] = pack2(o[2 * e], o[2 * e + 1]);
    *(u32x4*)(Kr + l * 72 + d0) = u.u;
  }
#pragma unroll 2
  for (int i = 0; i < 4; ++i) {
    int cc = tid + i * 256, l = cc >> 3, v0 = (cc & 7) * 8;
    U8 x; x.u = *(const u32x4*)(proj + (long)(b * S_ + c * 128 + l) * DINP_ + C_RV + h * 64 + v0);
#pragma unroll
    for (int e = 0; e < 8; ++e) Vt[(v0 + e) * TSTR + l] = x.s[e];
  }
  __syncthreads();
  f32x4 gacc[2][8];
#pragma unroll
  for (int ni = 0; ni < 8; ++ni) { gacc[0][ni] = (f32x4){0.f, 0.f, 0.f, 0.f}; gacc[1][ni] = (f32x4){0.f, 0.f, 0.f, 0.f}; }
#pragma unroll
  for (int ni = 0; ni < 8; ++ni) {
    if (ni < 2 * (wave + 1)) {
#pragma unroll
      for (int ks = 0; ks < 2; ++ks) {
        bf16x8 bb = *(const bf16x8*)(Kr + (ni * 16 + lr) * 72 + ks * 32 + quad * 8);
        gacc[0][ni] = MFMA(qf[0][ks], bb, gacc[0][ni]);
        gacc[1][ni] = MFMA(qf[1][ks], bb, gacc[1][ni]);
      }
    }
  }
  __syncthreads();
#pragma unroll
  for (int ni = 0; ni < 8; ++ni) {
    if (ni < 2 * (wave + 1)) {
      const int s = ni * 16 + lr;
#pragma unroll
      for (int mi = 0; mi < 2; ++mi)
#pragma unroll
        for (int j = 0; j < 4; ++j) {
          const int l = wave * 32 + mi * 16 + quad * 4 + j;
          float v = (s <= l) ? gacc[mi][ni][j] * __expf((float)(l - s) * lg) : 0.f;
          Sc[l * TSTR + s] = f2bf(v);
        }
    }
  }
  __syncthreads();
  f32x4 y[2][4];
#pragma unroll
  for (int mi = 0; mi < 2; ++mi)
#pragma unroll
    for (int ni = 0; ni < 4; ++ni) y[mi][ni] = (f32x4){0.f, 0.f, 0.f, 0.f};
  const float* prev = (const float*)(WSP(p) + OFF_R + R_RETST) + (long)((b * 64 + c) * 4 + h) * 4096;
#pragma unroll
  for (int ks = 0; ks < 2; ++ks)
#pragma unroll
    for (int ni = 0; ni < 4; ++ni) {
      const float4* pp = (const float4*)(prev + (ni * 16 + lr) * 64 + ks * 32 + quad * 8);
      float4 f0 = pp[0], f1 = pp[1];
      U8 u;
      u.w[0] = pack2(f0.x, f0.y); u.w[1] = pack2(f0.z, f0.w); u.w[2] = pack2(f1.x, f1.y); u.w[3] = pack2(f1.z, f1.w);
      y[0][ni] = MFMA(qf[0][ks], u.v, y[0][ni]);
      y[1][ni] = MFMA(qf[1][ks], u.v, y[1][ni]);
    }
#pragma unroll
  for (int mi = 0; mi < 2; ++mi)
#pragma unroll
    for (int j = 0; j < 4; ++j) {
      const float e = __expf((float)(wave * 32 + mi * 16 + quad * 4 + j + 1) * lg);
#pragma unroll
      for (int ni = 0; ni < 4; ++ni) y[mi][ni][j] *= e;
    }
#pragma unroll
  for (int ks = 0; ks < 4; ++ks) {
    if (ks < wave + 1) {
      bf16x8 a0 = *(const bf16x8*)(Sc + (wave * 32 + lr) * TSTR + ks * 32 + quad * 8);
      bf16x8 a1 = *(const bf16x8*)(Sc + (wave * 32 + 16 + lr) * TSTR + ks * 32 + quad * 8);
#pragma unroll
      for (int ni = 0; ni < 4; ++ni) {
        bf16x8 bb = *(const bf16x8*)(Vt + (ni * 16 + lr) * TSTR + ks * 32 + quad * 8);
        y[0][ni] = MFMA(a0, bb, y[0][ni]);
        y[1][ni] = MFMA(a1, bb, y[1][ni]);
      }
    }
  }
  u16* mix = (u16*)(WSP(p) + OFF_HBF);
#pragma unroll
  for (int mi = 0; mi < 2; ++mi)
#pragma unroll
    for (int j = 0; j < 4; ++j) {
      const int l = wave * 32 + mi * 16 + quad * 4 + j;
      const long tok = (long)b * S_ + c * 128 + l;
      float sq = 0.f;
#pragma unroll
      for (int ni = 0; ni < 4; ++ni) sq += y[mi][ni][j] * y[mi][ni][j];
      sq += __shfl_xor(sq, 1); sq += __shfl_xor(sq, 2); sq += __shfl_xor(sq, 4); sq += __shfl_xor(sq, 8);
      const float rs = rsqrtf(sq * (1.f / 64.f) + EPS_);
#pragma unroll
      for (int ni = 0; ni < 4; ++ni) {
        const int v = ni * 16 + lr;
        const float gt = silu_f(bf2f(proj[tok * DINP_ + C_RG + h * 64 + v]));
        mix[tok * 1024 + 512 + h * 64 + v] = f2bf(y[mi][ni][j] * rs * gt);
      }
    }
}

__device__ __forceinline__ void nsa_item(const Params& p, int item, char* smem) {
  const int b = item >> 8, t0 = (item & 255) * 32;
  const int tid = TIDX(), lane = tid & 63, wave = tid >> 6, lr = lane & 15, quad = lane >> 4;
  u16* Ks = (u16*)smem;
  u16* Vs = Ks + 64 * 72;
  float* imp = (float*)(smem + 18432);
  u64* selm = (u64*)(smem + 18432 + 16384);
  const u16* proj = PROJ(p);
  const int hq = lr & 3;
  const float slope = exp2f(-2.f * (float)(hq + 1)) * 1.4426950408889634f;
  const float c8 = 0.125f * 1.4426950408889634f;
  int tq[2];
  bf16x8 qf[2][2];
  float gt[2][3];
#pragma unroll
  for (int qt = 0; qt < 2; ++qt) {
    tq[qt] = t0 + wave * 8 + qt * 4 + (lr >> 2);
    const u16* row = proj + (long)(b * S_ + tq[qt]) * DINP_;
#pragma unroll
    for (int ks = 0; ks < 2; ++ks) {
      U8 x; x.u = *(const u32x4*)(row + C_NQ + hq * 64 + ks * 32 + quad * 8);
#pragma unroll
      for (int e = 0; e < 4; ++e) x.w[e] = pack2(bf2f(x.s[2 * e]) * c8, bf2f(x.s[2 * e + 1]) * c8);
      qf[ks][qt] = x.v;
    }
#pragma unroll
    for (int j = 0; j < 3; ++j) gt[qt][j] = sigm_f(bf2f(row[C_GATE + hq * 3 + j]));
  }
  f32x4* finl = (f32x4*)(smem + 18432 + 16384 + 512);
  __syncthreads();
  for (int i = tid; i < 4096; i += 256) imp[i] = 0.f;

  auto kf = [=](int kt, int ks) { return *(const bf16x8*)(Ks + (kt * 16 + lr) * 72 + ks * 32 + quad * 8); };
  auto vf = [=](int dt, int kk) {
    U8 u;
    u.d[0] = *(const u64*)(Vs + (dt * 16 + lr) * 72 + kk * 32 + quad * 4);
    u.d[1] = *(const u64*)(Vs + (dt * 16 + lr) * 72 + kk * 32 + 16 + quad * 4);
    return u.v;
  };
  auto kdst = [=](int c) { return (c >> 3) * 72 + (c & 7) * 8; };
  f32x4 o[4][2];
  float m[2], l[2];
  auto reset = [&]() {
#pragma unroll
    for (int dt = 0; dt < 4; ++dt) { o[dt][0] = (f32x4){0.f, 0.f, 0.f, 0.f}; o[dt][1] = (f32x4){0.f, 0.f, 0.f, 0.f}; }
    m[0] = m[1] = -1e30f; l[0] = l[1] = 0.f;
  };
  auto accum = [&](int gi) {
#pragma unroll
    for (int qt = 0; qt < 2; ++qt) {
      float lt = l[qt];
      lt += __shfl_xor(lt, 16);
      lt += __shfl_xor(lt, 32);
      const float sc = lt > 0.f ? gt[qt][gi] / lt : 0.f;
#pragma unroll
      for (int dt = 0; dt < 4; ++dt) {
        f32x4* fp = finl + ((wave * 32 + qt * 16 + lr) * 16 + dt * 4 + quad);
        if (gi == 0) *fp = o[dt][qt] * sc; else *fp = *fp + o[dt][qt] * sc;
      }
    }
  };

  const u16* kc = (const u16*)(WSP(p) + OFF_R + R_KCMP) + (long)b * 512 * 64;
  const u16* vct = (const u16*)(WSP(p) + OFF_R + R_VCT) + (long)b * 64 * 512;
  const int nvmax = t0 / 16 + 1;
  const int ntc = (nvmax + 63) >> 6;
  auto kcs = [=](int t, int c) { return kc + (long)(t * 64 + (c >> 3)) * 64 + (c & 7) * 8; };
  auto vcs = [=](int t, int c) { return vct + (long)(c >> 3) * 512 + t * 64 + (c & 7) * 8; };
  reset();
  const float slope16 = 16.f * slope;
  const int tw0 = t0 + wave * 8;
  const int jlw = tw0 >= 31 ? ((tw0 - 31) >> 4) : -1;
  flash_loop<2>(0, ntc, kcs, kdst, vcs, Ks, Vs, [&](int t) {
    const int jb = t * 64 + quad * 4;
    const int cl0 = (tq[0] >= 31 ? ((tq[0] - 31) >> 4) : -1) - jb, cl1 = (tq[1] >= 31 ? ((tq[1] - 31) >> 4) : -1) - jb;
    const float cf0 = -slope * ((float)(tq[0] - 16 * jb) - 15.5f), cf1 = -slope * ((float)(tq[1] - 16 * jb) - 15.5f);
    const float of0 = cf0 + ft_shift(m[0]), of1 = cf1 + ft_shift(m[1]);
    if (t * 64 + 63 > jlw) flash_tile2<2, false>(kf, vf, AlibiInit<true>{slope16, of0, of1, cl0, cl1, 1 << 20}, NoHook(), qf, o, m, l);
    else flash_tile2<2, false>(kf, vf, AlibiInit<false>{slope16, of0, of1, cl0, cl1, 1 << 20}, NoHook(), qf, o, m, l);
  });
  float invl[2];
#pragma unroll
  for (int qt = 0; qt < 2; ++qt) {
    float lt = l[qt];
    lt += __shfl_xor(lt, 16);
    lt += __shfl_xor(lt, 32);
    invl[qt] = lt > 0.f ? 1.f / lt : 0.f;
    l[qt] = 0.f;
  }
  flash_loop<2>(0, ntc, kcs, kdst, vcs, Ks, Vs, [&](int t) {
    const int jb = t * 64 + quad * 4;
    const int cl0 = (tq[0] >= 31 ? ((tq[0] - 31) >> 4) : -1) - jb, cl1 = (tq[1] >= 31 ? ((tq[1] - 31) >> 4) : -1) - jb;
    const float cf0 = -slope * ((float)(tq[0] - 16 * jb) - 15.5f), cf1 = -slope * ((float)(tq[1] - 16 * jb) - 15.5f);
    const float of0 = cf0 + ft_shift(m[0]), of1 = cf1 + ft_shift(m[1]);
    auto hook = [=](int qt, float (&pv)[4][4]) {
#pragma unroll
      for (int kt = 0; kt < 4; ++kt) {
        float v3 = pv[kt][3] * invl[qt];
        float vs = (pv[kt][0] + pv[kt][1] + pv[kt][2]) * invl[qt] + v3;
        vs += dpp_xor1(vs); vs += dpp_xor2(vs);
        v3 += dpp_xor1(v3); v3 += dpp_xor2(v3);
        if (hq == 0) {
          const int blk = t * 16 + kt * 4 + quad;
          float* ip = imp + (wave * 8 + qt * 4 + (lr >> 2)) * 128;
          atomicAdd(ip + blk, vs);
          if (blk + 1 < 128) atomicAdd(ip + blk + 1, v3);
        }
      }
    };
    if (t * 64 + 63 > jlw) flash_tile2<2, true>(kf, vf, AlibiInit<true>{slope16, of0, of1, cl0, cl1, 1 << 20}, hook, qf, o, m, l);
    else flash_tile2<2, true>(kf, vf, AlibiInit<false>{slope16, of0, of1, cl0, cl1, 1 << 20}, hook, qf, o, m, l);
  });
  accum(0);
  __syncthreads();

  unsigned* usel = (unsigned*)(smem + 18432 + 16384 + 512 + 32768);
  if (tid < 4) usel[tid] = 0u;
  unsigned ulo0 = 0, ulo1 = 0, uhi0 = 0, uhi1 = 0;
#pragma unroll 1
  for (int qi = 0; qi < 8; ++qi) {
    const int t = t0 + wave * 8 + qi, qblk = t >> 6;
    float* ip = imp + (wave * 8 + qi) * 128;
    unsigned k0, k1;
    {
      const int b0 = lane, b1 = lane + 64;
      const unsigned u0 = __float_as_uint(ip[lane]) & 0xFFFFFF80u, u1 = __float_as_uint(ip[64 + lane]) & 0xFFFFFF80u;
      k0 = (b0 > qblk) ? 0u : ((b0 == 0 || b0 == qblk || b0 == qblk - 1) ? 0xFFFFFF80u : u0);
      k1 = (b1 > qblk) ? 0u : ((b1 == qblk || b1 == qblk - 1) ? 0xFFFFFF80u : u1);
      k0 |= (unsigned)(127 - b0);
      k1 |= (unsigned)(127 - b1);
    }
    unsigned* kp = (unsigned*)ip;
    kp[lane] = k0; kp[64 + lane] = k1;
    asm volatile("s_waitcnt lgkmcnt(0)" ::: "memory");
    int r0 = 0, r1 = 0;
#pragma unroll 8
    for (int j4 = 0; j4 < 32; ++j4) {
      const u32x4 w = *(const u32x4*)(kp + j4 * 4);
#pragma unroll
      for (int e = 0; e < 4; ++e) {
        r0 += (w[e] > k0) ? 1 : 0;
        r1 += (w[e] > k1) ? 1 : 0;
      }
    }
    u64 mlo = __ballot(r0 < 16 && lane <= qblk);
    u64 mhi = __ballot(r1 < 16 && lane + 64 <= qblk);
    if (lane == 0) { selm[(wave * 8 + qi) * 2] = mlo; selm[(wave * 8 + qi) * 2 + 1] = mhi; }
    ulo0 |= (unsigned)mlo; ulo1 |= (unsigned)(mlo >> 32); uhi0 |= (unsigned)mhi; uhi1 |= (unsigned)(mhi >> 32);
  }
  __syncthreads();
  if (lane == 0) { atomicOr(usel + 0, ulo0); atomicOr(usel + 1, ulo1); atomicOr(usel + 2, uhi0); atomicOr(usel + 3, uhi1); }
  __syncthreads();
  u64 sm_lo[2], sm_hi[2];
#pragma unroll
  for (int qt = 0; qt < 2; ++qt) {
    sm_lo[qt] = selm[(wave * 8 + qt * 4 + (lr >> 2)) * 2];
    sm_hi[qt] = selm[(wave * 8 + qt * 4 + (lr >> 2)) * 2 + 1];
  }
  reset();
  {
    const u16* ksb = proj + (long)b * S_ * DINP_ + C_NKS;
    const u16* vst = (const u16*)(WSP(p) + OFF_VST) + (long)b * 64 * 8192;
    LAS int* blist = (LAS int*)imp;
    int nun = 0;
    {
      const unsigned u0 = usel[0], u1 = usel[1], u2 = usel[2], u3 = usel[3];
      __syncthreads();
      if (tid < 128) {
        const unsigned wd = tid < 32 ? u0 : tid < 64 ? u1 : tid < 96 ? u2 : u3;
        const int bit = tid & 31;
        if ((wd >> bit) & 1u) {
          int pos = __popc(wd & ((1u << bit) - 1u));
          if (tid >= 32) pos += __popc(u0);
          if (tid >= 64) pos += __popc(u1);
          if (tid >= 96) pos += __popc(u2);
          blist[pos] = tid;
        }
      }
      nun = __popc(u0) + __popc(u1) + __popc(u2) + __popc(u3);
      __syncthreads();
    }
    const unsigned w0m = __builtin_amdgcn_readfirstlane(ulo0), w1m = __builtin_amdgcn_readfirstlane(ulo1),
                   w2m = __builtin_amdgcn_readfirstlane(uhi0), w3m = __builtin_amdgcn_readfirstlane(uhi1);
    flash_loop<2>(0, nun,
        [=](int blk, int c) { return ksb + (long)(blk * 64 + (c >> 3)) * DINP_ + (c & 7) * 8; }, kdst,
        [=](int blk, int c) { return vst + (long)(c >> 3) * 8192 + blk * 64 + (c & 7) * 8; }, Ks, Vs,
        [&](int blk) {
          const unsigned wm = blk < 32 ? w0m : blk < 64 ? w1m : blk < 96 ? w2m : w3m;
          if ((wm >> (blk & 31)) & 1u) {
            const int k0 = blk * 64;
            const bool s0 = ((blk < 64 ? sm_lo[0] : sm_hi[0]) >> (blk & 63)) & 1ull;
            const bool s1 = ((blk < 64 ? sm_lo[1] : sm_hi[1]) >> (blk & 63)) & 1ull;
            const int l0 = tq[0] - k0 - quad * 4, l1 = tq[1] - k0 - quad * 4;
            const float f0 = s0 ? -slope * (float)l0 + ft_shift(m[0]) : -INFINITY, f1 = s1 ? -slope * (float)l1 + ft_shift(m[1]) : -INFINITY;
            if (k0 + 63 > tw0) flash_tile2<2, true>(kf, vf, AlibiInit<true>{slope, f0, f1, l0, l1, 1 << 20}, NoHook(), qf, o, m, l);
            else flash_tile2<2, true>(kf, vf, AlibiInit<false>{slope, f0, f1, l0, l1, 1 << 20}, NoHook(), qf, o, m, l);
          }
        }, [=](int t) { return (int)blist[t]; });
  }
  accum(1);
  reset();
  {
    const u16* kwb = proj + (long)b * S_ * DINP_ + C_NKW;
    const u16* vwt = (const u16*)(WSP(p) + OFF_VWT) + (long)b * 64 * 8192;
    const int w0 = (t0 >= 511 ? t0 - 511 : 0) >> 6, w1 = ((t0 + 31) >> 6) + 1;
    flash_loop<2>(w0, w1,
        [=](int t, int c) { return kwb + (long)(t * 64 + (c >> 3)) * DINP_ + (c & 7) * 8; }, kdst,
        [=](int t, int c) { return vwt + (long)(c >> 3) * 8192 + t * 64 + (c & 7) * 8; }, Ks, Vs,
        [&](int t) {
          const int l0 = tq[0] - t * 64 - quad * 4, l1 = tq[1] - t * 64 - quad * 4;
          const float f0 = -slope * (float)l0 + ft_shift(m[0]), f1 = -slope * (float)l1 + ft_shift(m[1]);
          if (t * 64 + 63 > tw0 || t * 64 <= tw0 + 7 - 512) flash_tile2<2, true>(kf, vf, AlibiInit<true>{slope, f0, f1, l0, l1, 512}, NoHook(), qf, o, m, l);
          else flash_tile2<2, true>(kf, vf, AlibiInit<false>{slope, f0, f1, l0, l1, 512}, NoHook(), qf, o, m, l);
        });
  }
  accum(2);
  u16* mix = (u16*)(WSP(p) + OFF_HBF);
#pragma unroll
  for (int qt = 0; qt < 2; ++qt) {
    u16* orow = mix + (long)(b * S_ + tq[qt]) * 1024 + 768 + hq * 64;
#pragma unroll
    for (int dt = 0; dt < 4; ++dt) {
      const f32x4 fv = finl[(wave * 32 + qt * 16 + lr) * 16 + dt * 4 + quad];
      u32x2 pk;
      pk.x = pack2(fv[0], fv[1]);
      pk.y = pack2(fv[2], fv[3]);
      *(u32x2*)(orow + dt * 16 + quad * 4) = pk;
    }
  }
}

__device__ __forceinline__ void phase4(const Params& p, int layer, char* smem) {
  int* cnt = (int*)(WSP(p) + OFF_CNT) + layer * 16;
  QLOOP(13, 384, mla_combine_item(p, it))
  QLOOP(10, 512, ssd_out_item(p, layer, it, smem))
  QLOOP_X(40, 64, nsa_item(p, qx * 64 + 63 - qd, smem))
  QLOOP(12, 512, ret_out_item(p, layer, it, smem))
}


#define XB_TMO      128
#define XB_XCNT(j)  (256  + 64 * (j))
#define XB_XSUB(j)  (1280 + 64 * (j))
#define XB_XGEN(j)  (2304 + 64 * (j))
#define XB_TOP      3328
#define XB_TOPGEN   3392
#define XCD_BAR_WORDS 3456
#define XB_SPIN_CAP (1u << 20)
__device__ __forceinline__ unsigned xb_ld(unsigned* p) { return __hip_atomic_load(p, __ATOMIC_RELAXED, __HIP_MEMORY_SCOPE_AGENT); }
__device__ __forceinline__ unsigned xb_add(unsigned* p, unsigned v) { return __hip_atomic_fetch_add(p, v, __ATOMIC_RELAXED, __HIP_MEMORY_SCOPE_AGENT); }
__device__ __forceinline__ unsigned xb_xcc_id() { return (unsigned)__builtin_amdgcn_s_getreg((3 << 11) | 20) & 0xFu; }
#define XB_SPIN(cond, bar) do { unsigned _sp = 0; while (cond) { __builtin_amdgcn_s_sleep(1); \
    if ((++_sp & 255u) == 0u) { if (xb_ld(&(bar)[XB_TMO])) break; if (_sp > XB_SPIN_CAP) { atomicAdd(&(bar)[XB_TMO], 1u); break; } } } } while (0)
struct XcdBarrier { unsigned* bar; unsigned x; volatile LAS unsigned* st; };
__device__ __forceinline__ XcdBarrier xcd_barrier_post(unsigned* bar, volatile LAS unsigned* st) {
  XcdBarrier b; b.bar = bar; b.x = xb_xcc_id(); b.st = st;
  if (__builtin_amdgcn_workitem_id_x() == 0) (void)xb_add(&bar[XB_XCNT(b.x)], 1u);
  return b;
}
__device__ __forceinline__ void xcd_barrier_complete(unsigned* bar, unsigned x, unsigned& nloc, unsigned& nx) {
  const unsigned G = gridDim.x * gridDim.y * gridDim.z;
  unsigned sum, cnt, mine, sp = 0u;
  for (;;) {
    sum = 0u; cnt = 0u; mine = 0u;
#pragma unroll
    for (unsigned j = 0; j < 16; ++j) { const unsigned c = xb_ld(&bar[XB_XCNT(j)]); sum += c; cnt += (c > 0u) ? 1u : 0u; mine = (j == x) ? c : mine; }
    if (sum == G) break;
    __builtin_amdgcn_s_sleep(1);
    if ((++sp & 255u) == 0u) { if (xb_ld(&bar[XB_TMO])) break; if (sp > XB_SPIN_CAP) { atomicAdd(&bar[XB_TMO], 1u); break; } }
  }
  nloc = mine > 0u ? mine : 1u; nx = cnt > 0u ? cnt : 1u;
}
__device__ __forceinline__ void xcd_barrier(const XcdBarrier& b) {
  asm volatile("s_waitcnt vmcnt(0)" ::: "memory");
  __syncthreads();
  if (__builtin_amdgcn_workitem_id_x() == 0) {
    unsigned* bar = b.bar;
    __builtin_amdgcn_s_waitcnt(0);
    unsigned nloc = b.st[0], nx = b.st[1];
    if (nloc == 0u) { xcd_barrier_complete(bar, b.x, nloc, nx); b.st[0] = nloc; b.st[1] = nx; }
    const unsigned old = xb_add(&bar[XB_XSUB(b.x)], 1u);
    const unsigned gen = old / nloc;
    if (old + 1u == (gen + 1u) * nloc) {
      __builtin_amdgcn_fence(__ATOMIC_RELEASE, "agent");
      asm volatile("s_waitcnt vmcnt(0)" ::: "memory");
      const unsigned og = xb_add(&bar[XB_TOP], 1u);
      const unsigned tg = og / nx;
      if (og + 1u == (tg + 1u) * nx) xb_add(&bar[XB_TOPGEN], 1u);
      else XB_SPIN(xb_ld(&bar[XB_TOPGEN]) == tg, bar);
      __builtin_amdgcn_fence(__ATOMIC_ACQUIRE, "agent");
      xb_add(&bar[XB_XGEN(b.x)], 1u);
      asm volatile("s_waitcnt vmcnt(0)" ::: "memory");
    } else {
      XB_SPIN(xb_ld(&bar[XB_XGEN(b.x)]) == gen, bar);
      __builtin_amdgcn_fence(__ATOMIC_ACQUIRE, "agent");
      asm volatile("s_waitcnt vmcnt(0)" ::: "memory");
    }
  }
  __syncthreads();
}

constexpr int NPHASE = 1 + 9 * 2;
template <int KIND>
__device__ __forceinline__ void run_kind(const Params& p, int layer, int bid, int nb, char* smem) {
  if (KIND == 9) phase0(p, bid, nb, smem);
  if (KIND == 0) phase_inproj(p, bid, nb, smem);
  if (KIND == 1) phase2(p, layer, smem);
  if (KIND == 2) phase3(p, layer, smem);
  if (KIND == 3) phase4(p, layer, smem);
  if (KIND == 4) phase_resgemm<true>(p, bid, nb, smem, (const u16*)(WSP(p) + OFF_HBF), 1024, (const u16*)(WSP(p) + OFF_WT_OUT),
                                     layer == 0 ? nullptr : (const float*)(WSP(p) + OFF_LNST) + (long)T_ * 2, INP(p, I_LN2G), INP(p, I_LN2B));
  if (KIND == 5) phase_ln(p, bid, nb, smem, INP(p, I_LN1G) + layer * 1024, INP(p, I_LN1B) + layer * 1024, -1, 0, false);
  if (KIND == 6) phase_mlp1(p, bid, nb, smem);
  if (KIND == 7) phase_resgemm<false>(p, bid, nb, smem, (const u16*)(WSP(p) + OFF_R), 4096, (const u16*)(WSP(p) + OFF_WT_M2),
                                      (const float*)(WSP(p) + OFF_LNST), INP(p, I_LN1G) + layer * 1024, INP(p, I_LN1B) + layer * 1024);
  if (KIND == 8) phase_ln(p, bid, nb, smem, INP(p, I_LN2G) + layer * 1024, INP(p, I_LN2B) + layer * 1024, layer == 0 ? 1 : -1, 1, layer == 1);
}

#if MEGA
__global__ void __launch_bounds__(256, 2) mega_kernel(Params p) {
  __shared__ __attribute__((aligned(16))) char smem[SMEM_BYTES];
  cg::grid_group grid = cg::this_grid();
  const int bid = blockIdx.x, nb = gridDim.x;
  volatile LAS unsigned* st = (volatile LAS unsigned*)(smem + SMEM_BYTES - 32);
  if (__builtin_amdgcn_workitem_id_x() == 0) { st[0] = 0u; st[1] = 0u; }
  __syncthreads();
  if (bid == 0) { unsigned* bw = (unsigned*)(p.ws + OFF_BAR); for (int i = __builtin_amdgcn_workitem_id_x(); i < XCD_BAR_WORDS; i += 256) bw[i] = 0u; }
  run_kind<9>(p, 0, bid, nb, smem);
  grid.sync();
  XcdBarrier xb = xcd_barrier_post((unsigned*)(p.ws + OFF_BAR), st);
#pragma unroll 1
  for (int layer = 0; layer < 2; ++layer) {
    run_kind<0>(p, layer, bid, nb, smem); xcd_barrier(xb);
    run_kind<1>(p, layer, bid, nb, smem); xcd_barrier(xb);
    run_kind<2>(p, layer, bid, nb, smem); xcd_barrier(xb);
    run_kind<3>(p, layer, bid, nb, smem); xcd_barrier(xb);
    run_kind<4>(p, layer, bid, nb, smem); xcd_barrier(xb);
    run_kind<5>(p, layer, bid, nb, smem); xcd_barrier(xb);
    run_kind<6>(p, layer, bid, nb, smem); xcd_barrier(xb);
    run_kind<7>(p, layer, bid, nb, smem); xcd_barrier(xb);
    run_kind<8>(p, layer, bid, nb, smem);
    if (layer == 0) xcd_barrier(xb);
  }
}
#else
template <int KIND>
__global__ void __launch_bounds__(256, 2) phase_kernel(Params p, int layer) {
  __shared__ __attribute__((aligned(16))) char smem[SMEM_BYTES];
  run_kind<KIND>(p, layer, blockIdx.x, gridDim.x, smem);
}
#endif

extern "C" void kernel_launch(void* const* d_in, const int* in_sizes, int n_in, void* d_out, int out_size, void* d_ws,
                              size_t ws_size, hipStream_t stream) {
  if (n_in != 27 || ws_size < WS_TOTAL) { fprintf(stderr, "kernel_launch: bad inputs n_in=%d ws=%zu need %zu\n", n_in, ws_size, (size_t)WS_TOTAL); return; }
  Params p{};
  for (int i = 0; i < 27; ++i) p.in[i] = (const float*)d_in[i];
  p.h32 = (float*)d_out;
  p.ws = (char*)d_ws;
#if MEGA
  static int grid_blocks = 0;
  if (!grid_blocks) {
    int dev = 0, cus = 0, per_cu = 0;
    hipGetDevice(&dev);
    hipDeviceGetAttribute(&cus, hipDeviceAttributeMultiprocessorCount, dev);
    hipOccupancyMaxActiveBlocksPerMultiprocessor(&per_cu, mega_kernel, 256, 0);
    if (per_cu > 2) per_cu = 2;
    grid_blocks = cus * per_cu;
    fprintf(stderr, "kernel_launch: cus=%d per_cu=%d grid=%d\n", cus, per_cu, grid_blocks);
  }
  void* args[] = {&p};
  hipError_t e = hipLaunchCooperativeKernel((void*)mega_kernel, dim3(grid_blocks), dim3(256), args, 0, stream);
  if (e != hipSuccess) fprintf(stderr, "cooperative launch failed: %s (grid %d)\n", hipGetErrorString(e), grid_blocks);
#else
  hipLaunchKernelGGL(phase_kernel<9>, dim3(512), dim3(256), 0, stream, p, 0);
  for (int layer = 0; layer < 2; ++layer) {
    hipLaunchKernelGGL(phase_kernel<0>, dim3(512), dim3(256), 0, stream, p, layer);
    hipLaunchKernelGGL(phase_kernel<1>, dim3(512), dim3(256), 0, stream, p, layer);
    hipLaunchKernelGGL(phase_kernel<2>, dim3(512), dim3(256), 0, stream, p, layer);
    hipLaunchKernelGGL(phase_kernel<3>, dim3(512), dim3(256), 0, stream, p, layer);
    hipLaunchKernelGGL(phase_kernel<4>, dim3(512), dim3(256), 0, stream, p, layer);
    hipLaunchKernelGGL(phase_kernel<5>, dim3(512), dim3(256), 0, stream, p, layer);
    hipLaunchKernelGGL(phase_kernel<6>, dim3(512), dim3(256), 0, stream, p, layer);
    hipLaunchKernelGGL(phase_kernel<7>, dim3(512), dim3(256), 0, stream, p, layer);
    hipLaunchKernelGGL(phase_kernel<8>, dim3(512), dim3(256), 0, stream, p, layer);
  }
#endif
}
```
